# Optimizing an MI355X kernel written in HIP

```python
import jax, jax.numpy as jnp
from jax import lax
import numpy as np

D_MODEL = 1024
BATCH = 8
SEQ = 4096
DEPTH = 2

HG_HEADS = 4
HG_KDIM = 128
HG_VDIM = 128
HG_CHUNK = 64
ATT_GROUPS = ((128, 1), (512, 4), (2048, 16))
N_GROUPS = 3
ATT_HEADS = 4
ATT_DIM = 128
ROPE_THETA = 500000.0
ROPE_DIM = ATT_DIM // 4
D_FF = 4 * D_MODEL
EPS = 1e-6

HG_QK_W = HG_HEADS * HG_KDIM
HG_V_W = HG_HEADS * HG_VDIM
ATT_W = ATT_HEADS * ATT_DIM
ATT_QKV_W = 3 * N_GROUPS * ATT_W
SPLITS = (HG_QK_W, HG_QK_W, HG_V_W, HG_V_W, ATT_QKV_W, D_MODEL, D_MODEL)
N_IN = HG_QK_W + HG_QK_W + HG_V_W + HG_V_W + ATT_QKV_W + D_MODEL + D_MODEL

kernel_name = "hybrid_hgrn2_dilated_swa_gated_block"


def rms_norm(x, g):
    xf = x.astype(jnp.float32)
    y = xf * lax.rsqrt(jnp.mean(xf * xf, axis=-1, keepdims=True) + EPS)
    return (y * g.astype(jnp.float32)).astype(x.dtype)


def partial_rope(t, cos, sin):
    tf = t.astype(jnp.float32)
    c = cos[:, None, :]
    s = sin[:, None, :]
    half = ROPE_DIM // 2
    r1 = tf[..., :half]
    r2 = tf[..., half:ROPE_DIM]
    out = jnp.concatenate([r1 * c - r2 * s, r2 * c + r1 * s, tf[..., ROPE_DIM:]], axis=-1)
    return out.astype(t.dtype)


def hgrn2_chunked(q, log_f, k, v):
    B, S, H, K = q.shape
    V = v.shape[-1]
    C = HG_CHUNK
    nc = S // C

    def chunks(t):
        return t.reshape(B, nc, C, H, t.shape[-1]).swapaxes(0, 1)

    causal = jnp.tril(jnp.ones((C, C), dtype=bool))[None, :, :, None, None]

    def step(state, xs):
        qc, gc, kc, vc = xs
        b = jnp.cumsum(gc, axis=1)
        rel = jnp.where(causal, b[:, :, None] - b[:, None, :], -jnp.inf)
        attn = jnp.einsum('bthk,btshk,bshk->bhts', qc, jnp.exp(rel), kc)
        o = (jnp.einsum('bhts,bshv->bthv', attn, vc)
             + jnp.einsum('bthk,bhkv->bthv', qc * jnp.exp(b), state))
        b_last = b[:, -1]
        k_dec = kc * jnp.exp(b_last[:, None] - b)
        state = state * jnp.exp(b_last)[..., None] + jnp.einsum('bshk,bshv->bhkv', k_dec, vc)
        return state, o

    state0 = jnp.zeros((B, H, K, V), jnp.float32)
    _, o = lax.scan(step, state0, (chunks(q), chunks(log_f), chunks(k), chunks(v)))
    return o.swapaxes(0, 1).reshape(B, S, H, V)


def dilated_window_attention(q, k, v, window, dilation):
    B, S, H, Dh = q.shape
    L = window // dilation
    period = dilation * L
    Sp = -(-S // period) * period
    M = Sp // dilation
    nb = M // L
    pad = Sp - S

    def to_blocks(t):
        t = jnp.pad(t, ((0, 0), (0, pad), (0, 0), (0, 0)))
        t = t.reshape(B, M, dilation, H, Dh)
        t = t.transpose(0, 2, 3, 1, 4)
        return t.reshape(B, dilation, H, nb, L, Dh)

    def with_prev(t):
        prev = jnp.pad(t, ((0, 0), (0, 0), (0, 0), (1, 0), (0, 0), (0, 0)))[:, :, :, :-1]
        return jnp.concatenate([prev, t], axis=4)

    qb = to_blocks(q).astype(jnp.float32)
    kw = with_prev(to_blocks(k)).astype(jnp.float32)
    vw = with_prev(to_blocks(v)).astype(jnp.float32)

    scores = jnp.einsum('bzhnqd,bzhnkd->bzhnqk', qb, kw) * (Dh ** -0.5)
    i = jnp.arange(L)[:, None]
    j = jnp.arange(2 * L)[None, :]
    delta = L + i - j
    band = (delta >= 0) & (delta <= L)
    n = jnp.arange(nb)[:, None, None]
    mask = band[None] & ((n > 0) | (j[None] >= L))
    scores = jnp.where(mask, scores, -jnp.inf)
    m = jnp.max(scores, axis=-1, keepdims=True)
    p = jnp.exp(scores - m)
    den = jnp.sum(p, axis=-1, keepdims=True)
    o = jnp.einsum('bzhnqk,bzhnkd->bzhnqd', p, vw) / den
    lse = (m + jnp.log(den))[..., 0]

    o = o.reshape(B, dilation, H, M, Dh).transpose(0, 3, 1, 2, 4).reshape(B, Sp, H, Dh)[:, :S]
    lse = lse.reshape(B, dilation, H, M).transpose(0, 3, 1, 2).reshape(B, Sp, H)[:, :S]
    return o, lse


def setup_inputs(seed: int = 0) -> dict:
    key = jax.random.key(seed)
    ks = jax.random.split(key, 13)
    f32 = jnp.float32
    nrm = lambda k, shape, scale: jax.random.normal(k, shape, f32) * scale
    return {
        "x": nrm(ks[0], (BATCH, SEQ, D_MODEL), 1.0),
        "norm1_g": 1.0 + nrm(ks[1], (DEPTH, D_MODEL), 0.02),
        "w_in": nrm(ks[2], (DEPTH, D_MODEL, N_IN), D_MODEL ** -0.5),
        "hg_lower_bounds": nrm(ks[3], (DEPTH, HG_QK_W), 1.0),
        "hg_norm_g": 1.0 + nrm(ks[4], (DEPTH, HG_V_W), 0.02),
        "w_branch_a": nrm(ks[5], (DEPTH, HG_V_W, D_MODEL), HG_V_W ** -0.5),
        "w_branch_b": nrm(ks[6], (DEPTH, ATT_W, D_MODEL), ATT_W ** -0.5),
        "w_out": nrm(ks[7], (DEPTH, D_MODEL, D_MODEL), D_MODEL ** -0.5),
        "norm2_g": 1.0 + nrm(ks[8], (DEPTH, D_MODEL), 0.02),
        "w_up": nrm(ks[9], (DEPTH, D_MODEL, D_FF), D_MODEL ** -0.5),
        "w_down": nrm(ks[10], (DEPTH, D_FF, D_MODEL), D_FF ** -0.5),
        "final_norm_g": 1.0 + nrm(ks[11], (D_MODEL,), 0.02),
    }


def reference(x, norm1_g, w_in, hg_lower_bounds, hg_norm_g, w_branch_a, w_branch_b,
              w_out, norm2_g, w_up, w_down, final_norm_g):
    B, S, _ = x.shape
    f32 = jnp.float32
    split_idx = [int(c) for c in np.cumsum(SPLITS)[:-1]]

    pos = jnp.arange(S, dtype=f32)
    inv_freq = ROPE_THETA ** (-jnp.arange(0, ROPE_DIM, 2, dtype=f32) / ROPE_DIM)
    ang = pos[:, None] * inv_freq[None, :]
    cos, sin = jnp.cos(ang), jnp.sin(ang)

    lb_all = jnp.cumsum(jax.nn.softmax(hg_lower_bounds.astype(f32), axis=0), axis=0)
    lb_all = lb_all - lb_all[0:1]

    for l in range(DEPTH):
        h = rms_norm(x, norm1_g[l])
        z = h @ w_in[l]
        zq, zf, zi, zg, zatt, za, zb = jnp.split(z, split_idx, axis=-1)

        q_hg = jax.nn.silu(zq.astype(f32)).reshape(B, S, HG_HEADS, HG_KDIM)
        lb = lb_all[l]
        log_f = jnp.logaddexp(jnp.log(lb), jnp.log1p(-lb) + jax.nn.log_sigmoid(zf.astype(f32)))
        log_f = log_f.reshape(B, S, HG_HEADS, HG_KDIM)
        k_hg = -jnp.expm1(log_f)
        v_hg = zi.astype(f32).reshape(B, S, HG_HEADS, HG_VDIM)
        o_hg = hgrn2_chunked(q_hg, log_f, k_hg, v_hg)
        o_hg = rms_norm(o_hg, hg_norm_g[l].reshape(HG_HEADS, HG_VDIM))
        o_hg = o_hg * jax.nn.sigmoid(zg.astype(f32)).reshape(B, S, HG_HEADS, HG_VDIM)
        o_hg = o_hg.reshape(B, S, HG_V_W).astype(x.dtype)

        qkv = zatt.reshape(B, S, 3, N_GROUPS, ATT_HEADS, ATT_DIM)
        outs, lses = [], []
        for g, (window, dilation) in enumerate(ATT_GROUPS):
            qg = partial_rope(qkv[:, :, 0, g], cos, sin)
            kg = partial_rope(qkv[:, :, 1, g], cos, sin)
            vg = qkv[:, :, 2, g]
            o_g, lse_g = dilated_window_attention(qg, kg, vg, window, dilation)
            outs.append(o_g)
            lses.append(lse_g)
        w_grp = jax.nn.softmax(jnp.stack(lses, axis=0), axis=0)
        o_att = jnp.sum(w_grp[..., None] * jnp.stack(outs, axis=0), axis=0)
        o_att = o_att.reshape(B, S, ATT_W).astype(x.dtype)

        y = (jax.nn.sigmoid(za) * (o_hg @ w_branch_a[l])
             + jax.nn.sigmoid(zb) * (o_att @ w_branch_b[l]))
        x = x + y @ w_out[l]

        h2 = rms_norm(x, norm2_g[l])
        x = x + jnp.square(jax.nn.relu(h2 @ w_up[l])) @ w_down[l]

    return rms_norm(x, final_norm_g)
```

```cpp
#include <hip/hip_runtime.h>
#include <hip/hip_cooperative_groups.h>
#include <cstdio>
#include <cstdint>
namespace cg = cooperative_groups;
namespace pg8 {
#define PG8_LAS __attribute__((address_space(3)))
typedef unsigned short bf16_t;
typedef short bf16x8 __attribute__((ext_vector_type(8)));
typedef float f32x4 __attribute__((ext_vector_type(4)));
typedef unsigned u32x4 __attribute__((ext_vector_type(4)));
constexpr int BM = 256, BK = 64, HALF = 128, HTB = HALF * BK * 2  , STAGE_BYTES = 8 * HTB, NXCD = 8, WGM = 4;

__host__ __device__ __forceinline__ int lds_byte(int r, int c) { const int st = (r >> 4) * 2 + (c >> 5), rr = r & 15, cc = c & 31, ob = rr * 64 + cc * 2; return st * 1024 + (ob ^ (((ob >> 9) & 1) << 5)); }
__host__ __device__ __forceinline__ void stage_rc(int b, int& R, int& C) { const int st = b / 1024, sb = b % 1024, swz = sb ^ (((sb >> 9) & 1) << 5); R = (st >> 1) * 16 + swz / 64; C = (st & 1) * 32 + (swz % 64) / 2; }
__host__ __device__ __forceinline__ int perm32(int rho) { const int n = rho >> 4, i = rho & 15; return 8 * (i >> 2) + 4 * n + (i & 3); }

struct Unit { int pm, pn, sel; };
struct Gemm { const bf16_t* A; const bf16_t* Bt; int M, N, K; int bld; const bf16_t* A2; const bf16_t* Bt2; };
__device__ __forceinline__ size_t btile_off(int pn, int bld, int K) { const int p0 = pn * 256, b = p0 >> 12, w = p0 & 4095, sh = 12 - bld, r = w >> sh, m0 = w & ((1 << sh) - 1); return (size_t)(b * 4096 + r + (m0 << bld)) * (size_t)K * 2; }

struct StaticOrder {
    int nM, nN, nwg, G, c;
    __host__ __device__ void init(int M, int N, int G_, int c_) { nM = M / BM; nN = N / BM; nwg = nM * nN; G = G_; c = c_; }
    __host__ __device__ bool next(int i, Unit& u) const {
        const long L = (long)i * G + c; if (L >= nwg) return false;
        int wgid = (int)L; { const int q = nwg / NXCD, r = nwg % NXCD, xcd = wgid % NXCD, off = wgid / NXCD; wgid = (xcd < r ? xcd * (q + 1) : r * (q + 1) + (xcd - r) * q) + off; }
        const int nig = WGM * nN, gid = wgid / nig, fm = gid * WGM, gsz = (nM - fm) < WGM ? (nM - fm) : WGM;
        u.pm = fm + ((wgid % nig) % gsz); u.pn = (wgid % nig) / gsz; u.sel = 0; return true;
    }
    __device__ __forceinline__ void a_ready(const Unit&) const {}
    __device__ __forceinline__ void done(const Unit&) const {}
};

struct ChainOrder { StaticOrder base;
    __device__ void init(int M, int N, int G_, int c_) { base.init(M, N, G_, c_); }
    __device__ bool next(int i, Unit& u) const { if (!base.next(i >> 1, u)) return false; u.sel = i & 1; return true; }
    __device__ __forceinline__ void a_ready(const Unit&) const {}
    __device__ __forceinline__ void done(const Unit&) const {} };
__device__ __forceinline__ unsigned cvt_pk_bf16(float lo, float hi) { unsigned r; asm volatile("v_cvt_pk_bf16_f32 %0, %1, %2" : "=v"(r) : "v"(lo), "v"(hi)); return r; }
template <class Epi, class Sched, bool ALIGN_EPI = false, bool SP2 = false>
__device__ __forceinline__ void gemm_phase(PG8_LAS unsigned char* lds, const Gemm g, const Sched& S, const Epi& E) {
    int tid_ = threadIdx.x; asm volatile("" : "+v"(tid_));
    const int tid = tid_, wid = __builtin_amdgcn_readfirstlane(tid >> 6), lane = tid & 63, wr = wid >> 2, wc = wid & 3, fr = lane & 15, fq = lane >> 4;
    const int K = g.K, nt = K / BK;
    unsigned voffA[2], voffB[2];
#pragma unroll
    for (int i = 0; i < 2; ++i) { int R, C; stage_rc(tid * 16 + i * 8192, R, C); const int Rb = Epi::PERM ? ((R & ~31) + perm32(R & 31)) : R;
        voffA[i] = (unsigned)(R * K + C) * 2u; voffB[i] = (unsigned)((Rb << g.bld) * K + C) * 2u; }
    const size_t kstep = (size_t)(BK * 2);
    const size_t hstep = (size_t)HALF * K * 2;
    const size_t tstep = 2 * hstep; const size_t hstepB = hstep << g.bld;
    const unsigned ldsw = (unsigned)wid * 1024u;
    const int aoff = lds_byte(wr * 64 + fr, fq * 8), boff = lds_byte(wc * 32 + fr, fq * 8);
#define PG8_SA(b, h) (((b) * 2 + (h)) * HTB)
#define PG8_SB(b, h) ((4 + (b) * 2 + (h)) * HTB)
#define PG8_STAGE(bufoff, gbase, voff) do { _Pragma("unroll") for (int _i = 0; _i < 2; ++_i) \
        __builtin_amdgcn_global_load_lds((const unsigned*)((const char*)(gbase) + (voff)[_i]), (PG8_LAS unsigned*)(lds + (bufoff) + ldsw + _i * 8192), 16, 0, 0); } while (0)
#define PG8_LDA(dst, b, h) do { _Pragma("unroll") for (int m = 0; m < 4; ++m) _Pragma("unroll") for (int k = 0; k < 2; ++k) dst[m][k] = *(const PG8_LAS bf16x8*)(lds + PG8_SA(b, h) + aoff + m * 2048 + k * 1024); } while (0)
#define PG8_LDB(dst, b, h) do { _Pragma("unroll") for (int n = 0; n < 2; ++n) _Pragma("unroll") for (int k = 0; k < 2; ++k) dst[n][k] = *(const PG8_LAS bf16x8*)(lds + PG8_SB(b, h) + boff + n * 2048 + k * 1024); } while (0)
#define PG8_MMA(ai, bj, At, Bt) do { __builtin_amdgcn_s_setprio(1); _Pragma("unroll") for (int m = 0; m < 4; ++m) _Pragma("unroll") for (int n = 0; n < 2; ++n) _Pragma("unroll") for (int k = 0; k < 2; ++k) \
        acc[ai][bj][m][n] = __builtin_amdgcn_mfma_f32_16x16x32_bf16(Bt[n][k], At[m][k], acc[ai][bj][m][n], 0, 0, 0); __builtin_amdgcn_s_setprio(0); } while (0)
#define PG8_WAIT_V(n) asm volatile("s_waitcnt vmcnt(" #n ")" ::: "memory")
#define PG8_WAIT_L(n) asm volatile("s_waitcnt lgkmcnt(" #n ")" ::: "memory")
#define PG8_BAR __builtin_amdgcn_s_barrier()
#define PG8_SCHED __builtin_amdgcn_sched_barrier(0)
    Unit cur, nxt; int ui = 0;
    if (!S.next(0, cur)) return;
    f32x4 acc[2][2][4][2];
#pragma unroll
    for (int a = 0; a < 2; ++a)
#pragma unroll
        for (int b = 0; b < 2; ++b)
#pragma unroll
            for (int m = 0; m < 4; ++m)
#pragma unroll
                for (int n = 0; n < 2; ++n) acc[a][b][m][n] = (f32x4){0.f, 0.f, 0.f, 0.f};
    bf16x8 At[4][2], B0[2][2], B1[2][2];
    const char* cA = (const char*)(cur.sel ? g.A2 : g.A) + (size_t)cur.pm * tstep; const char* cB = (const char*)(cur.sel ? g.Bt2 : g.Bt) + btile_off(cur.pn, g.bld, K);
    S.a_ready(cur);
    if constexpr (SP2) {
        PG8_STAGE(PG8_SB(0, 0), cB, voffB); PG8_STAGE(PG8_SB(0, 1), cB + hstepB, voffB); PG8_STAGE(PG8_SA(0, 0), cA, voffA); PG8_STAGE(PG8_SA(0, 1), cA + hstep, voffA);
        if (wr == 1) PG8_BAR;
        PG8_WAIT_V(2); PG8_BAR;
        PG8_STAGE(PG8_SB(1, 0), cB + kstep, voffB); PG8_STAGE(PG8_SA(1, 0), cA + kstep, voffA); PG8_STAGE(PG8_SB(1, 1), cB + hstepB + kstep, voffB);
        PG8_WAIT_V(6); PG8_BAR;
    } else {
        PG8_STAGE(PG8_SB(0, 0), cB, voffB); PG8_STAGE(PG8_SA(0, 0), cA, voffA); PG8_STAGE(PG8_SB(0, 1), cB + hstepB, voffB); PG8_STAGE(PG8_SA(0, 1), cA + hstep, voffA);
        if (wr == 1) PG8_BAR;
        PG8_WAIT_V(4); PG8_BAR;
        PG8_STAGE(PG8_SB(1, 0), cB + kstep, voffB); PG8_STAGE(PG8_SA(1, 0), cA + kstep, voffA); PG8_STAGE(PG8_SB(1, 1), cB + hstepB + kstep, voffB);
        PG8_WAIT_V(6); PG8_BAR;
    }
    for (;;) {
        const bool has_next = S.next(ui + 1, nxt);
        const char* nA = has_next ? (const char*)(nxt.sel ? g.A2 : g.A) + (size_t)nxt.pm * tstep : cA; const char* nB = has_next ? (const char*)(nxt.sel ? g.Bt2 : g.Bt) + btile_off(nxt.pn, g.bld, K) : cB;
        for (int t = 0; t < nt; t += 2) {
            const bool last = (t == nt - 2);
            const char* a1 = cA + (size_t)(t + 1) * kstep;
            const char* a2 = last ? nA : cA + (size_t)(t + 2) * kstep; const char* b2 = last ? nB : cB + (size_t)(t + 2) * kstep;
            const char* a3 = a2 + kstep; const char* b3 = b2 + kstep;
            if (last && has_next) S.a_ready(nxt);
            if constexpr (SP2) {
            PG8_LDB(B0, 0, 0); PG8_LDB(B1, 0, 1); PG8_SCHED; PG8_LDA(At, 0, 0); PG8_STAGE(PG8_SA(1, 1), a1 + hstep, voffA);
            PG8_WAIT_V(8); PG8_WAIT_L(0); PG8_BAR; PG8_MMA(0, 0, At, B0); PG8_MMA(0, 1, At, B1); PG8_BAR; PG8_SCHED;
            PG8_LDA(At, 0, 1); PG8_STAGE(PG8_SB(0, 0), b2, voffB); PG8_STAGE(PG8_SB(0, 1), b2 + hstepB, voffB); PG8_STAGE(PG8_SA(0, 0), a2, voffA);
            PG8_WAIT_V(8); PG8_WAIT_L(0); PG8_BAR; PG8_MMA(1, 0, At, B0); PG8_MMA(1, 1, At, B1); PG8_BAR; PG8_SCHED;
            PG8_LDB(B0, 1, 0); PG8_LDB(B1, 1, 1); PG8_SCHED; PG8_LDA(At, 1, 0); PG8_STAGE(PG8_SA(0, 1), a2 + hstep, voffA);
            PG8_WAIT_V(8); PG8_WAIT_L(0); PG8_BAR; PG8_MMA(0, 0, At, B0); PG8_MMA(0, 1, At, B1); PG8_BAR; PG8_SCHED;
            PG8_LDA(At, 1, 1); PG8_STAGE(PG8_SB(1, 0), b3, voffB); PG8_STAGE(PG8_SB(1, 1), b3 + hstepB, voffB); PG8_STAGE(PG8_SA(1, 0), a3, voffA);
            PG8_WAIT_V(8); PG8_WAIT_L(0); PG8_BAR; PG8_MMA(1, 0, At, B0); PG8_MMA(1, 1, At, B1); PG8_BAR; PG8_SCHED;
            } else {
            PG8_LDB(B0, 0, 0); PG8_SCHED; PG8_LDA(At, 0, 0); PG8_STAGE(PG8_SA(1, 1), a1 + hstep, voffA);
            PG8_WAIT_L(8); PG8_BAR; PG8_WAIT_L(0); PG8_MMA(0, 0, At, B0); PG8_BAR; PG8_SCHED;
            PG8_LDB(B1, 0, 1); PG8_STAGE(PG8_SB(0, 0), b2, voffB);
            PG8_BAR; PG8_WAIT_L(0); PG8_MMA(0, 1, At, B1); PG8_BAR;
            PG8_LDA(At, 0, 1); PG8_STAGE(PG8_SA(0, 0), a2, voffA);
            PG8_BAR; PG8_WAIT_L(0); PG8_MMA(1, 0, At, B0); PG8_BAR; PG8_SCHED;
            PG8_STAGE(PG8_SB(0, 1), b2 + hstepB, voffB);
            PG8_WAIT_V(6); PG8_BAR; PG8_MMA(1, 1, At, B1); PG8_BAR;
            PG8_LDB(B0, 1, 0); PG8_SCHED; PG8_LDA(At, 1, 0); PG8_STAGE(PG8_SA(0, 1), a2 + hstep, voffA);
            PG8_WAIT_L(8); PG8_BAR; PG8_WAIT_L(0); PG8_MMA(0, 0, At, B0); PG8_BAR; PG8_SCHED;
            PG8_LDB(B1, 1, 1); PG8_STAGE(PG8_SB(1, 0), b3, voffB);
            PG8_BAR; PG8_WAIT_L(0); PG8_MMA(0, 1, At, B1); PG8_BAR;
            PG8_LDA(At, 1, 1); PG8_STAGE(PG8_SA(1, 0), a3, voffA);
            PG8_BAR; PG8_WAIT_L(0); PG8_MMA(1, 0, At, B0); PG8_BAR; PG8_SCHED;
            PG8_STAGE(PG8_SB(1, 1), b3 + hstepB, voffB);
            PG8_WAIT_V(6); PG8_BAR; PG8_MMA(1, 1, At, B1); PG8_BAR;
            }
        }
        if constexpr (ALIGN_EPI) { if (wr == 0) PG8_BAR; }
        if constexpr (!Epi::AFTER_DRAIN) { int fr_ = fr, fq_ = fq; asm volatile("" : "+v"(fr_), "+v"(fq_));
            if constexpr (Epi::CHAIN) { if (cur.sel == 0) E.mid(acc, cur, wr, wc, fr_, fq_); else E(acc, cur, wr, wc, fr_, fq_); } else E(acc, cur, wr, wc, fr_, fq_);
            S.done(cur); }
        if (!has_next) break;
        if (!(Epi::CHAIN && cur.sel == 0))
#pragma unroll
        for (int a = 0; a < 2; ++a)
#pragma unroll
            for (int b = 0; b < 2; ++b)
#pragma unroll
                for (int m = 0; m < 4; ++m)
#pragma unroll
                    for (int n = 0; n < 2; ++n) acc[a][b][m][n] = (f32x4){0.f, 0.f, 0.f, 0.f};
        cur = nxt; cA = nA; cB = nB; ++ui;
        if constexpr (ALIGN_EPI) { if (wr == 1) PG8_BAR; }
    }
    PG8_WAIT_V(0);
    if constexpr (!ALIGN_EPI) { if (wr == 0) PG8_BAR; }
    PG8_BAR;
    if constexpr (Epi::AFTER_DRAIN) { E.fused(acc, cur, wr, wc, fr, fq, lds, wid, lane); S.done(cur); }
#undef PG8_SA
#undef PG8_SB
#undef PG8_STAGE
#undef PG8_LDA
#undef PG8_LDB
#undef PG8_MMA
#undef PG8_WAIT_V
#undef PG8_WAIT_L
#undef PG8_BAR
#undef PG8_SCHED
}
}

#ifndef REP_SYNC
#define REP_SYNC 1
#endif
#ifndef REP_PRO
#define REP_PRO 1
#endif
#ifndef REP_P3
#define REP_P3 1
#endif
#ifndef REP_AU
#define REP_AU 1
#endif
#ifndef REP_HA
#define REP_HA 1
#endif
#ifndef REP_HS
#define REP_HS 1
#endif
#ifndef REP_HC
#define REP_HC 1
#endif
#ifndef REP_G1
#define REP_G1 1
#endif
#ifndef REP_ATT
#define REP_ATT 1
#endif
#ifndef REP_HG
#define REP_HG 1
#endif
#ifndef REP_P5
#define REP_P5 1
#endif
#define LAS __attribute__((address_space(3)))
typedef unsigned short bf16;
typedef pg8::bf16x8 bf16x8;
typedef pg8::f32x4 f32x4;
typedef unsigned u32x4 __attribute__((ext_vector_type(4)));
typedef unsigned u32x2 __attribute__((ext_vector_type(2)));
typedef float f32x2_t __attribute__((ext_vector_type(2)));
typedef __bf16 bf16x2_t __attribute__((ext_vector_type(2)));
typedef _Float16 f16x2_t __attribute__((ext_vector_type(2)));

constexpr int DM = 1024, SEQ = 4096, GB = 4, MP = GB * SEQ, NPASS = 2, FF = 4096;
constexpr int ZC = 4608, GC = 2048;
constexpr int NMAIN = 6656, NV = 2048, NIN = 8704;
constexpr float EPS = 1e-6f;
constexpr float QSCALE = 0.08838834764831845f * 1.4426950408889634f;
constexpr size_t MiB = 1u << 20;
constexpr size_t WS_SSQ = 494 * MiB;
constexpr size_t WS_LB = 704 * 1024;
constexpr size_t WS_BAR = 768 * 1024;
constexpr size_t WS_COS = 1 * MiB, WS_SIN = 1 * MiB + 256 * 1024;
constexpr size_t WS_W = 2 * MiB;
constexpr size_t L_ELEMS = 19398656;
constexpr size_t W_MAIN = 0, W_V = 6815744, W_A = 8912896, W_B = 9437184, W_OUT = 9961472, W_UP = 11010048, W_DOWN = 15204352;
constexpr size_t WS_XB = 76 * MiB;
constexpr size_t WS_Z = 108 * MiB;
constexpr size_t WS_GT = 252 * MiB;
constexpr size_t WS_VT = 316 * MiB;
constexpr size_t WS_OHG = 380 * MiB, WS_OATT = 396 * MiB;
constexpr size_t WS_KVT = 412 * MiB;
constexpr size_t WS_DEC = 476 * MiB;
constexpr size_t WS_OG2 = 477 * MiB;
constexpr size_t WS_LSE = 493 * MiB;
constexpr size_t WS_END = 505 * MiB;
constexpr int LDS_BYTES = 147456;

__device__ __forceinline__ unsigned pkbf(float lo, float hi) { f32x2_t v = {lo, hi}; bf16x2_t b = __builtin_convertvector(v, bf16x2_t); return __builtin_bit_cast(unsigned, b); }
__device__ __forceinline__ unsigned pkh(float lo, float hi) { f16x2_t v = {(_Float16)lo, (_Float16)hi}; return __builtin_bit_cast(unsigned, v); }
__device__ __forceinline__ float bflo(unsigned w) { return __uint_as_float(w << 16); }
__device__ __forceinline__ float bfhi(unsigned w) { return __uint_as_float(w & 0xffff0000u); }
__device__ __forceinline__ float bf1(bf16 h) { return __uint_as_float((unsigned)h << 16); }
__device__ __forceinline__ float sigm(float x) { return __builtin_amdgcn_rcpf(1.f + __expf(-x)); }
__device__ __forceinline__ float wave_sum(float v) {
#pragma unroll
    for (int o = 1; o < 64; o <<= 1) v += __shfl_xor(v, o);
    return v;
}
__device__ __forceinline__ float row_rs4(const float* ssq, int row, int fq) { const f32x4 a = *(const f32x4*)(ssq + (size_t)row * 16 + 4 * fq); float s = (a[0] + a[1]) + (a[2] + a[3]);
    s += __shfl_xor(s, 16); s += __shfl_xor(s, 32); return rsqrtf(s * (1.0f / 1024.0f) + 1e-6f); }
__device__ __forceinline__ float rs4_finish(f32x4 a) { float s = (a[0] + a[1]) + (a[2] + a[3]); s += __shfl_xor(s, 16); s += __shfl_xor(s, 32); return rsqrtf(s * (1.0f / 1024.0f) + 1e-6f); }
__device__ __forceinline__ float tok_rs16(const float* ssq, int t, int fr) { float s = ssq[(size_t)t * 16 + fr];
    s += __shfl_xor(s, 1); s += __shfl_xor(s, 2); s += __shfl_xor(s, 4); s += __shfl_xor(s, 8); return rsqrtf(s * (1.0f / 1024.0f) + 1e-6f); }
#define MFMA16(a, b, c) __builtin_amdgcn_mfma_f32_16x16x32_bf16((a), (b), (c), 0, 0, 0)

using pg8::Unit;
struct EpiMain {
    static constexpr bool PERM = true, AFTER_DRAIN = false, CHAIN = false;
    bf16* Z; bf16* Gt; const float* ssq; const float* lb; const float* rc; const float* rs;
    __device__ __forceinline__ void operator()(const f32x4 (&acc)[2][2][4][2], const Unit& u, int wr, int wc, int fr, int fq) const {
        const int pn = u.pn;
        bf16* base; int ldc, colt, kind;
        if (pn < 18) { base = Z; ldc = ZC; colt = pn * 256; } else { base = Gt; ldc = GC; colt = (pn - 18) * 256; }
        kind = pn < 2 ? 0 : pn < 4 ? 1 : pn < 6 ? 2 : pn < 12 ? 3 : pn < 18 ? 4 : 2;
        const int row0 = u.pm * 256 + wr * 64 + fr, col0 = colt + wc * 32 + 8 * fq;
        const bool rope = (kind == 3 || kind == 4) && (wc == 0);
        const float sgn = (fq < 2) ? -1.f : 1.f;
        float rsv[2][4]; f32x4 pvv[2][4];
#pragma unroll
        for (int ai = 0; ai < 2; ++ai)
#pragma unroll
            for (int m = 0; m < 4; ++m) pvv[ai][m] = *(const f32x4*)(ssq + (size_t)(row0 + ai * 128 + m * 16) * 16 + 4 * fq);
#pragma unroll
        for (int ai = 0; ai < 2; ++ai)
#pragma unroll
            for (int m = 0; m < 4; ++m) rsv[ai][m] = rs4_finish(pvv[ai][m]);
        f32x4 lbq[2][2] = {{{0.f, 0.f, 0.f, 0.f}, {0.f, 0.f, 0.f, 0.f}}, {{0.f, 0.f, 0.f, 0.f}, {0.f, 0.f, 0.f, 0.f}}};
        if (kind == 1) {
#pragma unroll
            for (int bj = 0; bj < 2; ++bj) { const float* lbp = lb + (pn - 2) * 256 + bj * 128 + wc * 32 + 8 * fq; lbq[bj][0] = *(const f32x4*)lbp; lbq[bj][1] = *(const f32x4*)(lbp + 4); } }
        f32x4 i0 = {0.f, 0.f, 0.f, 0.f}, i1 = {0.f, 0.f, 0.f, 0.f};
        if (rope) { i0 = *(const f32x4*)(rc + 8 * (fq & 1)); i1 = *(const f32x4*)(rc + 8 * (fq & 1) + 4); }
        asm volatile("" ::: "memory");
#pragma unroll
        for (int ai = 0; ai < 2; ++ai)
#pragma unroll
            for (int m = 0; m < 4; ++m) {
                const int row = row0 + ai * 128 + m * 16;
                const float rsc = rsv[ai][m];
                bf16* rowp = base + (size_t)row * ldc + col0;
#pragma unroll
                for (int bj = 0; bj < 2; ++bj) {
                    float v[8];
#pragma unroll
                    for (int e = 0; e < 4; ++e) { v[e] = acc[ai][bj][m][0][e] * rsc; v[4 + e] = acc[ai][bj][m][1][e] * rsc; }
                    u32x4 w;
                    if (kind == 0) {
#pragma unroll
                        for (int e = 0; e < 8; ++e) v[e] = v[e] * sigm(v[e]);
                        w.x = pkbf(v[0], v[1]); w.y = pkbf(v[2], v[3]); w.z = pkbf(v[4], v[5]); w.w = pkbf(v[6], v[7]);
                    } else if (kind == 1) {
                        const f32x4 l0 = lbq[bj][0], l1 = lbq[bj][1];
#pragma unroll
                        for (int e = 0; e < 8; ++e) { const float lv = e < 4 ? l0[e] : l1[e - 4]; const float f = lv + (1.f - lv) * sigm(v[e]); v[e] = logf(fmaxf(f, 1e-30f)); }
                        w.x = pkh(v[0], v[1]); w.y = pkh(v[2], v[3]); w.z = pkh(v[4], v[5]); w.w = pkh(v[6], v[7]);
                    } else if (kind == 2) {
#pragma unroll
                        for (int e = 0; e < 8; ++e) v[e] = sigm(v[e]);
                        w.x = pkbf(v[0], v[1]); w.y = pkbf(v[2], v[3]); w.z = pkbf(v[4], v[5]); w.w = pkbf(v[6], v[7]);
                    } else {
                        if (rope) {
                            const float posf = (float)(row & 4095);
#pragma unroll
                            for (int e = 0; e < 8; ++e) { const float pv = __shfl_xor(v[e], 32); const float rev = __builtin_amdgcn_fractf((posf * (e < 4 ? i0[e] : i1[e - 4])) * 0.15915494309189535f);
                                const float cc = __builtin_amdgcn_cosf(rev), ss = __builtin_amdgcn_sinf(rev); v[e] = v[e] * cc + sgn * pv * ss; }
                        }
                        if (kind == 3) {
#pragma unroll
                            for (int e = 0; e < 8; ++e) v[e] *= QSCALE;
                        }
                        w.x = pkbf(v[0], v[1]); w.y = pkbf(v[2], v[3]); w.z = pkbf(v[4], v[5]); w.w = pkbf(v[6], v[7]);
                    }
                    *(u32x4*)(rowp + bj * 128) = w;
                }
            }
    }
};
struct EpiVT {
    static constexpr bool PERM = true, AFTER_DRAIN = false, CHAIN = false;
    bf16* VT; const float* ssq; int rowoff, bld;
    __device__ __forceinline__ void operator()(const f32x4 (&acc)[2][2][4][2], const Unit& u, int wr, int wc, int fr, int fq) const {
        const int row0 = rowoff + u.pm * 256 + wr * 64 + fr, p0 = u.pn * 256 + wc * 32 + 8 * fq;
        const int sh = 12 - bld;
        float scv[2][8];
#pragma unroll
        for (int bj = 0; bj < 2; ++bj)
#pragma unroll
            for (int e = 0; e < 8; ++e) { const int p = p0 + bj * 128 + e, b = p >> 12, w = p & 4095, r = w >> sh, mm = w & ((1 << sh) - 1); const int t = b * 4096 + (mm << bld) + r; scv[bj][e] = tok_rs16(ssq, t, fr); }
        asm volatile("" ::: "memory");
#pragma unroll
        for (int bj = 0; bj < 2; ++bj) {
            float sc[8];
#pragma unroll
            for (int e = 0; e < 8; ++e) sc[e] = scv[bj][e];
#pragma unroll
            for (int ai = 0; ai < 2; ++ai)
#pragma unroll
                for (int m = 0; m < 4; ++m) {
                    const f32x4 a0 = acc[ai][bj][m][0], a1 = acc[ai][bj][m][1]; u32x4 w;
                    w.x = pkbf(a0[0] * sc[0], a0[1] * sc[1]); w.y = pkbf(a0[2] * sc[2], a0[3] * sc[3]); w.z = pkbf(a1[0] * sc[4], a1[1] * sc[5]); w.w = pkbf(a1[2] * sc[6], a1[3] * sc[7]);
                    *(u32x4*)(VT + (size_t)(row0 + ai * 128 + m * 16) * MP + p0 + bj * 128) = w;
                }
        }
    }
};
struct EpiGateA {
    static constexpr bool PERM = true, AFTER_DRAIN = false, CHAIN = false;
    bf16* tmp; const bf16* Gt;
    __device__ __forceinline__ void operator()(const f32x4 (&acc)[2][2][4][2], const Unit& u, int wr, int wc, int fr, int fq) const {
        const int row0 = u.pm * 256 + wr * 64 + fr, col0 = u.pn * 256 + wc * 32 + 8 * fq;
#pragma unroll
        for (int ai = 0; ai < 2; ++ai)
#pragma unroll
            for (int m = 0; m < 4; ++m) { const int row = row0 + ai * 128 + m * 16;
#pragma unroll
                for (int bj = 0; bj < 2; ++bj) { const int col = col0 + bj * 128; const u32x4 g = *(const u32x4*)(Gt + (size_t)row * GC + col);
                    const f32x4 a0 = acc[ai][bj][m][0], a1 = acc[ai][bj][m][1]; u32x4 w;
                    w.x = pkbf(a0[0] * bflo(g.x), a0[1] * bfhi(g.x)); w.y = pkbf(a0[2] * bflo(g.y), a0[3] * bfhi(g.y));
                    w.z = pkbf(a1[0] * bflo(g.z), a1[1] * bfhi(g.z)); w.w = pkbf(a1[2] * bflo(g.w), a1[3] * bfhi(g.w));
                    *(u32x4*)(tmp + (size_t)row * DM + col) = w; } }
    }
};
struct EpiGateB {
    static constexpr bool PERM = true, AFTER_DRAIN = false, CHAIN = false;
    const bf16* tmp; const bf16* Gt; bf16* Y;
    __device__ __forceinline__ void operator()(const f32x4 (&acc)[2][2][4][2], const Unit& u, int wr, int wc, int fr, int fq) const {
        const int row0 = u.pm * 256 + wr * 64 + fr, col0 = u.pn * 256 + wc * 32 + 8 * fq;
#pragma unroll
        for (int ai = 0; ai < 2; ++ai)
#pragma unroll
            for (int m = 0; m < 4; ++m) { const int row = row0 + ai * 128 + m * 16;
#pragma unroll
                for (int bj = 0; bj < 2; ++bj) { const int col = col0 + bj * 128; const u32x4 g = *(const u32x4*)(Gt + (size_t)row * GC + 1024 + col);
                    const u32x4 t = *(const u32x4*)(tmp + (size_t)row * DM + col);
                    const f32x4 a0 = acc[ai][bj][m][0], a1 = acc[ai][bj][m][1]; u32x4 w;
                    w.x = pkbf(bflo(t.x) + a0[0] * bflo(g.x), bfhi(t.x) + a0[1] * bfhi(g.x)); w.y = pkbf(bflo(t.y) + a0[2] * bflo(g.y), bfhi(t.y) + a0[3] * bfhi(g.y));
                    w.z = pkbf(bflo(t.z) + a1[0] * bflo(g.z), bfhi(t.z) + a1[1] * bfhi(g.z)); w.w = pkbf(bflo(t.w) + a1[2] * bflo(g.w), bfhi(t.w) + a1[3] * bfhi(g.w));
                    *(u32x4*)(Y + (size_t)row * DM + col) = w; } }
    }
};
struct EpiGateChain {
    static constexpr bool PERM = true, AFTER_DRAIN = false, CHAIN = true;
    const bf16* Gt; bf16* Y;
    __device__ __forceinline__ void mid(f32x4 (&acc)[2][2][4][2], const Unit& u, int wr, int wc, int fr, int fq) const {
        const int row0 = u.pm * 256 + wr * 64 + fr, col0 = u.pn * 256 + wc * 32 + 8 * fq;
#pragma unroll
        for (int ai = 0; ai < 2; ++ai)
#pragma unroll
            for (int m = 0; m < 4; ++m) { const int row = row0 + ai * 128 + m * 16;
#pragma unroll
                for (int bj = 0; bj < 2; ++bj) { const bf16* gp = Gt + (size_t)row * GC + col0 + bj * 128; const u32x4 ga = *(const u32x4*)gp, gb = *(const u32x4*)(gp + 1024);
                    f32x4 r0, r1;
                    r0[0] = bflo(ga.x) * __builtin_amdgcn_rcpf(fmaxf(bflo(gb.x), 1e-30f)); r0[1] = bfhi(ga.x) * __builtin_amdgcn_rcpf(fmaxf(bfhi(gb.x), 1e-30f));
                    r0[2] = bflo(ga.y) * __builtin_amdgcn_rcpf(fmaxf(bflo(gb.y), 1e-30f)); r0[3] = bfhi(ga.y) * __builtin_amdgcn_rcpf(fmaxf(bfhi(gb.y), 1e-30f));
                    r1[0] = bflo(ga.z) * __builtin_amdgcn_rcpf(fmaxf(bflo(gb.z), 1e-30f)); r1[1] = bfhi(ga.z) * __builtin_amdgcn_rcpf(fmaxf(bfhi(gb.z), 1e-30f));
                    r1[2] = bflo(ga.w) * __builtin_amdgcn_rcpf(fmaxf(bflo(gb.w), 1e-30f)); r1[3] = bfhi(ga.w) * __builtin_amdgcn_rcpf(fmaxf(bfhi(gb.w), 1e-30f));
                    acc[ai][bj][m][0] = acc[ai][bj][m][0] * r0; acc[ai][bj][m][1] = acc[ai][bj][m][1] * r1; } }
    }
    __device__ __forceinline__ void operator()(const f32x4 (&acc)[2][2][4][2], const Unit& u, int wr, int wc, int fr, int fq) const {
        const int row0 = u.pm * 256 + wr * 64 + fr, col0 = u.pn * 256 + wc * 32 + 8 * fq;
#pragma unroll
        for (int ai = 0; ai < 2; ++ai) {
        u32x4 gv[4][2];
#pragma unroll
            for (int m = 0; m < 4; ++m)
#pragma unroll
                for (int bj = 0; bj < 2; ++bj) gv[m][bj] = *(const u32x4*)(Gt + (size_t)(row0 + ai * 128 + m * 16) * GC + 1024 + col0 + bj * 128);
        asm volatile("" ::: "memory");
#pragma unroll
            for (int m = 0; m < 4; ++m) { const int row = row0 + ai * 128 + m * 16;
#pragma unroll
                for (int bj = 0; bj < 2; ++bj) { const int col = col0 + bj * 128; const u32x4 g = gv[m][bj];
                    const f32x4 a0 = acc[ai][bj][m][0], a1 = acc[ai][bj][m][1]; u32x4 w;
                    w.x = pkbf(a0[0] * bflo(g.x), a0[1] * bfhi(g.x)); w.y = pkbf(a0[2] * bflo(g.y), a0[3] * bfhi(g.y));
                    w.z = pkbf(a1[0] * bflo(g.z), a1[1] * bfhi(g.z)); w.w = pkbf(a1[2] * bflo(g.w), a1[3] * bfhi(g.w));
                    *(u32x4*)(Y + (size_t)row * DM + col) = w; } }
        asm volatile("" ::: "memory"); }
    }
};
struct EpiRes {
    static constexpr bool PERM = true, AFTER_DRAIN = false, CHAIN = false;
    bf16* xb; float* ssq;
    __device__ __forceinline__ void operator()(const f32x4 (&acc)[2][2][4][2], const Unit& u, int wr, int wc, int fr, int fq) const {
        const int row0 = u.pm * 256 + wr * 64 + fr, col0 = u.pn * 256 + wc * 32 + 8 * fq;
#pragma unroll
        for (int ai = 0; ai < 2; ++ai) {
        u32x4 xv[4][2];
#pragma unroll
            for (int m = 0; m < 4; ++m)
#pragma unroll
                for (int bj = 0; bj < 2; ++bj) xv[m][bj] = *(const u32x4*)(xb + (size_t)(row0 + ai * 128 + m * 16) * DM + col0 + bj * 128);
        asm volatile("" ::: "memory");
#pragma unroll
            for (int m = 0; m < 4; ++m) { const int row = row0 + ai * 128 + m * 16; float s = 0.f;
#pragma unroll
                for (int bj = 0; bj < 2; ++bj) { bf16* p = xb + (size_t)row * DM + col0 + bj * 128; const u32x4 x = xv[m][bj];
                    const f32x4 a0 = acc[ai][bj][m][0], a1 = acc[ai][bj][m][1];
                    const float o0 = bflo(x.x) + a0[0], o1 = bfhi(x.x) + a0[1], o2 = bflo(x.y) + a0[2], o3 = bfhi(x.y) + a0[3];
                    const float o4 = bflo(x.z) + a1[0], o5 = bfhi(x.z) + a1[1], o6 = bflo(x.w) + a1[2], o7 = bfhi(x.w) + a1[3];
                    u32x4 w; w.x = pkbf(o0, o1); w.y = pkbf(o2, o3); w.z = pkbf(o4, o5); w.w = pkbf(o6, o7); *(u32x4*)p = w;
                    s += ((o0 * o0 + o1 * o1) + (o2 * o2 + o3 * o3)) + ((o4 * o4 + o5 * o5) + (o6 * o6 + o7 * o7)); }
                s += __shfl_xor(s, 16); s += __shfl_xor(s, 32);
                if (fq == 0) ssq[(size_t)row * 16 + u.pn * 4 + wc] = s; }
        asm volatile("" ::: "memory"); }
    }
};
struct EpiUp {
    static constexpr bool PERM = true, AFTER_DRAIN = false, CHAIN = false;
    bf16* U; const float* ssq;
    __device__ __forceinline__ void operator()(const f32x4 (&acc)[2][2][4][2], const Unit& u, int wr, int wc, int fr, int fq) const {
        const int row0 = u.pm * 256 + wr * 64 + fr, col0 = u.pn * 256 + wc * 32 + 8 * fq;
        float rsv[2][4]; f32x4 pvv[2][4];
#pragma unroll
        for (int ai = 0; ai < 2; ++ai)
#pragma unroll
            for (int m = 0; m < 4; ++m) pvv[ai][m] = *(const f32x4*)(ssq + (size_t)(row0 + ai * 128 + m * 16) * 16 + 4 * fq);
#pragma unroll
        for (int ai = 0; ai < 2; ++ai)
#pragma unroll
            for (int m = 0; m < 4; ++m) rsv[ai][m] = rs4_finish(pvv[ai][m]);
        asm volatile("" ::: "memory");
#pragma unroll
        for (int ai = 0; ai < 2; ++ai)
#pragma unroll
            for (int m = 0; m < 4; ++m) { const int row = row0 + ai * 128 + m * 16; const float rsc = rsv[ai][m];
#pragma unroll
                for (int bj = 0; bj < 2; ++bj) { float v[8];
#pragma unroll
                    for (int e = 0; e < 4; ++e) { v[e] = fmaxf(acc[ai][bj][m][0][e] * rsc, 0.f); v[4 + e] = fmaxf(acc[ai][bj][m][1][e] * rsc, 0.f); }
#pragma unroll
                    for (int e = 0; e < 8; ++e) v[e] *= v[e];
                    u32x4 w; w.x = pkbf(v[0], v[1]); w.y = pkbf(v[2], v[3]); w.z = pkbf(v[4], v[5]); w.w = pkbf(v[6], v[7]);
                    *(u32x4*)(U + (size_t)row * FF + col0 + bj * 128) = w; } }
    }
};

#define XB_TMO      128
#define XB_XCNT(j)  (256  + 64 * (j))
#define XB_XSUB(j)  (1280 + 64 * (j))
#define XB_XGEN(j)  (2304 + 64 * (j))
#define XB_TOP      3328
#define XB_TOPGEN   3392
#define XCD_BAR_WORDS 3456
#define XB_SPIN_CAP (1u << 18)

__device__ __forceinline__ unsigned xb_ld(unsigned* p)              { return __hip_atomic_load(p, __ATOMIC_RELAXED, __HIP_MEMORY_SCOPE_AGENT); }
__device__ __forceinline__ unsigned xb_add(unsigned* p, unsigned v) { return __hip_atomic_fetch_add(p, v, __ATOMIC_RELAXED, __HIP_MEMORY_SCOPE_AGENT); }
__device__ __forceinline__ unsigned xb_xcc_id() { return (unsigned)__builtin_amdgcn_s_getreg((3 << 11) | 20) & 0xFu; }
#define XB_SPIN(cond, bar) do { unsigned _sp = 0; while (cond) { __builtin_amdgcn_s_sleep(1); \
    if ((++_sp & 255u) == 0u) { if (xb_ld(&(bar)[XB_TMO])) break; if (_sp > XB_SPIN_CAP) { atomicAdd(&(bar)[XB_TMO], 1u); break; } } } } while (0)

struct XcdBarrier {
    unsigned* bar; unsigned x;
    volatile LAS unsigned* st;
};

__device__ __forceinline__ XcdBarrier xcd_barrier_post(unsigned* bar, volatile LAS unsigned* st) {
    XcdBarrier b; b.bar = bar; b.x = xb_xcc_id(); b.st = st;
    if (threadIdx.x == 0) (void)xb_add(&bar[XB_XCNT(b.x)], 1u);
    return b;
}
__device__ __forceinline__ void xcd_barrier_complete(unsigned* bar, unsigned x, unsigned& nloc, unsigned& nx) {
    const unsigned G = gridDim.x * gridDim.y * gridDim.z;
    unsigned sum, cnt, mine, sp = 0u;
    for (;;) {
        sum = 0u; cnt = 0u; mine = 0u;
#pragma unroll
        for (unsigned j = 0; j < 16; ++j) { const unsigned c = xb_ld(&bar[XB_XCNT(j)]); sum += c; cnt += (c > 0u) ? 1u : 0u; mine = (j == x) ? c : mine; }
        if (sum == G) break;
        __builtin_amdgcn_s_sleep(1);
        if ((++sp & 255u) == 0u) { if (xb_ld(&bar[XB_TMO])) break; if (sp > XB_SPIN_CAP) { atomicAdd(&bar[XB_TMO], 1u); break; } }
    }
    nloc = mine > 0u ? mine : 1u; nx = cnt > 0u ? cnt : 1u;
}

__device__ __forceinline__ void xcd_barrier(const XcdBarrier& b) {
    asm volatile("s_waitcnt vmcnt(0)" ::: "memory");
    __syncthreads();
    if (threadIdx.x == 0) {
        unsigned* bar = b.bar;
        __builtin_amdgcn_s_waitcnt(0);
        unsigned nloc = b.st[0], nx = b.st[1];
        if (nloc == 0u) { xcd_barrier_complete(bar, b.x, nloc, nx); b.st[0] = nloc; b.st[1] = nx; }
        const unsigned old = xb_add(&bar[XB_XSUB(b.x)], 1u);
        const unsigned gen = old / nloc;
        if (old + 1u == (gen + 1u) * nloc) {
            __builtin_amdgcn_fence(__ATOMIC_RELEASE, "agent");
            asm volatile("s_waitcnt vmcnt(0)" ::: "memory");
            const unsigned og = xb_add(&bar[XB_TOP], 1u);
            const unsigned tg = og / nx;
            if (og + 1u == (tg + 1u) * nx) xb_add(&bar[XB_TOPGEN], 1u);
            else XB_SPIN(xb_ld(&bar[XB_TOPGEN]) == tg, bar);
            __builtin_amdgcn_fence(__ATOMIC_ACQUIRE, "agent");
            xb_add(&bar[XB_XGEN(b.x)], 1u);
            asm volatile("s_waitcnt vmcnt(0)" ::: "memory");
        } else {
            XB_SPIN(xb_ld(&bar[XB_XGEN(b.x)]) == gen, bar);
            __builtin_amdgcn_fence(__ATOMIC_ACQUIRE, "agent");
            asm volatile("s_waitcnt vmcnt(0)" ::: "memory");
        }
    }
    __syncthreads();
}

__device__ __forceinline__ void tr_item(const float* W, int ldw, int K, int k0, int nsrc0, bf16* WT, int ndst0, const float* gain, LAS float* scr, int lane) {
    float v[32];
    const float* wp = W + (size_t)(k0 + (lane >> 5)) * ldw + nsrc0 + (lane & 31);
#pragma unroll
    for (int i = 0; i < 32; ++i) v[i] = wp[(size_t)(2 * i) * ldw];
    if (gain) {
        const float* gp = gain + k0 + (lane >> 5);
#pragma unroll
        for (int i = 0; i < 32; ++i) v[i] *= gp[2 * i];
    }
#pragma unroll
    for (int i = 0; i < 32; ++i) scr[(2 * i + (lane >> 5)) * 33 + (lane & 31)] = v[i];
    asm volatile("s_waitcnt lgkmcnt(0)" ::: "memory");
    const int c = lane & 7;
#pragma unroll
    for (int j = 0; j < 4; ++j) { const int n = (lane >> 3) + 8 * j; const LAS float* s = scr + (8 * c) * 33 + n;
        u32x4 o; o.x = pkbf(s[0 * 33], s[1 * 33]); o.y = pkbf(s[2 * 33], s[3 * 33]); o.z = pkbf(s[4 * 33], s[5 * 33]); o.w = pkbf(s[6 * 33], s[7 * 33]);
        *(u32x4*)(WT + (size_t)(ndst0 + n) * K + k0 + 8 * c) = o; }
    asm volatile("s_waitcnt lgkmcnt(0)" ::: "memory");
}
__device__ __forceinline__ void xb_row(const float* xrow, bf16* orow, float* ssq, int lane) {
    const f32x4* xr = (const f32x4*)xrow + lane; f32x4 v[4]; float s = 0.f;
#pragma unroll
    for (int j = 0; j < 4; ++j) { v[j] = xr[64 * j]; s += (v[j][0] * v[j][0] + v[j][1] * v[j][1]) + (v[j][2] * v[j][2] + v[j][3] * v[j][3]); }
    s = wave_sum(s);
    u32x2* o = (u32x2*)orow + lane;
#pragma unroll
    for (int j = 0; j < 4; ++j) { u32x2 w; w.x = pkbf(v[j][0], v[j][1]); w.y = pkbf(v[j][2], v[j][3]); o[64 * j] = w; }
    if (lane < 16) ssq[lane] = lane == 0 ? s : 0.f;
}
__device__ __forceinline__ void final_row(const bf16* xrow, float* orow, const float* g, int lane) {
    const u32x2* xr = (const u32x2*)xrow + lane; const f32x4* gr = (const f32x4*)g + lane; f32x4 v[4]; float s = 0.f;
#pragma unroll
    for (int j = 0; j < 4; ++j) { const u32x2 w = xr[64 * j]; v[j] = (f32x4){bflo(w.x), bfhi(w.x), bflo(w.y), bfhi(w.y)}; s += (v[j][0] * v[j][0] + v[j][1] * v[j][1]) + (v[j][2] * v[j][2] + v[j][3] * v[j][3]); }
    s = wave_sum(s); const float r = rsqrtf(s * (1.0f / 1024.0f) + EPS);
    f32x4* o = (f32x4*)orow + lane;
#pragma unroll
    for (int j = 0; j < 4; ++j) o[64 * j] = v[j] * r * gr[64 * j];
}

#define LBAR() do { asm volatile("s_waitcnt lgkmcnt(0)" ::: "memory"); __builtin_amdgcn_s_barrier(); asm volatile("" ::: "memory"); } while (0)
__device__ __forceinline__ void hgrn_a_loads(const bf16* zbuf, int ch, int tid, unsigned (&lw)[8]) {
    const int bl = ch >> 8, h = (ch >> 6) & 3, c = ch & 63, m0 = bl * 4096 + c * 64, kp = tid & 63, seg = tid >> 6;
    const bf16* lfp = zbuf + (size_t)(m0 + 8 * seg) * ZC + 512 + h * 128 + 2 * kp;
#pragma unroll
    for (int i = 0; i < 8; ++i) lw[i] = *(const unsigned*)(lfp + (size_t)i * ZC);
}
__device__ __forceinline__ void hgrn_passA(LAS unsigned char* lds, const bf16* zbuf, const bf16* VT, bf16* KVT, float* dec, int ch, int nxt, unsigned (&lw)[8]) {
    int tid = threadIdx.x; asm volatile("" : "+v"(tid)); const int wid = __builtin_amdgcn_readfirstlane(tid >> 6), lane = tid & 63;
    const int bl = ch >> 8, h = (ch >> 6) & 3, c = ch & 63, m0 = bl * 4096 + c * 64;
    LAS float* segsum = (LAS float*)lds; LAS unsigned char* kdT = lds + 4096;
    const int kp = tid & 63, k0 = 2 * kp, seg = tid >> 6;
    const int i16 = lane & 15, kq = lane >> 4, v0 = 16 * wid;
    const bf16* vp = VT + (size_t)(h * 128 + v0 + i16) * MP + m0 + 8 * kq;
    const bf16x8 a0 = *(const bf16x8*)vp, a1 = *(const bf16x8*)(vp + 32);
    float lfa[8], lfb[8]; float ra = 0.f, rb = 0.f;
#pragma unroll
    for (int i = 0; i < 8; ++i) { const f16x2_t hv = __builtin_bit_cast(f16x2_t, lw[i]); lfa[i] = (float)hv[0]; lfb[i] = (float)hv[1]; ra += lfa[i]; rb += lfb[i]; }
    *(LAS f32x2_t*)(segsum + seg * 128 + k0) = (f32x2_t){ra, rb};
    if (nxt < 1024) hgrn_a_loads(zbuf, nxt, tid, lw);
    LBAR();
    float offa = 0.f, offb = 0.f, bla = 0.f, blb = 0.f;
#pragma unroll
    for (int s = 0; s < 8; ++s) { const f32x2_t sv = *(const LAS f32x2_t*)(segsum + s * 128 + k0); if (s < seg) { offa += sv[0]; offb += sv[1]; } bla += sv[0]; blb += sv[1]; }
    float kda[8], kdb[8]; float ba = offa, bb = offb;
#pragma unroll
    for (int i = 0; i < 8; ++i) { ba += lfa[i]; bb += lfb[i]; kda[i] = (1.f - __expf(lfa[i])) * __expf(bla - ba); kdb[i] = (1.f - __expf(lfb[i])) * __expf(blb - bb); }
    u32x4 w0, w1; w0.x = pkbf(kda[0], kda[1]); w0.y = pkbf(kda[2], kda[3]); w0.z = pkbf(kda[4], kda[5]); w0.w = pkbf(kda[6], kda[7]);
    w1.x = pkbf(kdb[0], kdb[1]); w1.y = pkbf(kdb[2], kdb[3]); w1.z = pkbf(kdb[4], kdb[5]); w1.w = pkbf(kdb[6], kdb[7]);
    *(LAS u32x4*)(kdT + k0 * 144 + seg * 16) = w0; *(LAS u32x4*)(kdT + (k0 + 1) * 144 + seg * 16) = w1;
    if (seg == 0) *(f32x2_t*)(dec + ch * 128 + k0) = (f32x2_t){__expf(bla), __expf(blb)};
    LBAR();
    bf16* outp = KVT + (size_t)ch * 16384 + wid * 2048 + i16 * 8 + (kq >> 1) * 128 + (kq & 1) * 4;
#pragma unroll
    for (int kt = 0; kt < 8; ++kt) {
        f32x4 acc = {0.f, 0.f, 0.f, 0.f};
        const LAS unsigned char* bp = kdT + (16 * kt + i16) * 144 + 16 * kq;
        acc = MFMA16(*(const LAS bf16x8*)bp, a0, acc); acc = MFMA16(*(const LAS bf16x8*)(bp + 64), a1, acc);
        u32x2 w; w.x = pkbf(acc[0], acc[1]); w.y = pkbf(acc[2], acc[3]); *(u32x2*)(outp + 256 * kt) = w;
    }
    LBAR();
}
__device__ __forceinline__ void hgrn_scan(const bf16* KVT, const float* dec, bf16* ST, int gid, int gstride) {
    asm volatile("" : "+v"(gid));
    for (int id = gid; id < 16 * 8192; id += gstride) {
        const int bh = id >> 13, e2 = id & 8191, idx = 2 * e2, k = ((idx >> 9) & 3) * 32 + ((idx & 511) >> 7) * 8 + (idx & 7);
        float sa = 0.f, sb = 0.f;
#pragma unroll 8
        for (int c = 0; c < 64; ++c) { const int ch = bh * 64 + c;
            *(unsigned*)(ST + (size_t)ch * 16384 + idx) = pkbf(sa, sb);
            const f32x2_t d = *(const f32x2_t*)(dec + ch * 128 + k); const unsigned kv = *(const unsigned*)(KVT + (size_t)ch * 16384 + idx);
            sa = d[0] * sa + bflo(kv); sb = d[1] * sb + bfhi(kv); }
    }
}
__device__ __forceinline__ void hgrn_c_loads(const bf16* zbuf, int ch, int tid, unsigned (&lw)[8], unsigned (&qw)[8]) {
    const int bl = ch >> 8, h = (ch >> 6) & 3, c = ch & 63, m0 = bl * 4096 + c * 64, kp = tid & 63, seg = tid >> 6;
    const bf16* zp = zbuf + (size_t)(m0 + 8 * seg) * ZC + h * 128 + 2 * kp;
#pragma unroll
    for (int i = 0; i < 8; ++i) { lw[i] = *(const unsigned*)(zp + (size_t)i * ZC + 512); qw[i] = *(const unsigned*)(zp + (size_t)i * ZC); }
}
__device__ __forceinline__ void hgrn_passC(LAS unsigned char* lds, const bf16* zbuf, const bf16* VT, const bf16* ST, const float* hgg, bf16* ohg, int ch, int nxt, unsigned (&lw)[8], unsigned (&qw)[8]) {
    int tid = threadIdx.x; asm volatile("" : "+v"(tid)); const int wid = __builtin_amdgcn_readfirstlane(tid >> 6), lane = tid & 63;
    const int bl = ch >> 8, h = (ch >> 6) & 3, c = ch & 63, m0 = bl * 4096 + c * 64;
    constexpr int PITCH = 272;
    LAS float* segsum = (LAS float*)lds; LAS float* ssqL = (LAS float*)(lds + 4096);
    LAS unsigned char* qbL = lds + 8192; LAS unsigned char* kbL = qbL + 64 * PITCH; LAS unsigned char* qsL = kbL + 64 * PITCH;
    const int kp = tid & 63, k0 = 2 * kp, seg = tid >> 6;
    const int j = lane & 15, kq = lane >> 4, tt = wid & 3, vh = wid >> 2, t0 = 16 * tt;
    LAS unsigned char* stF = lds + 65536;
    LAS unsigned char* vtF = lds + 98304;
    {   const bf16* sp = ST + (size_t)ch * 16384 + wid * 2048 + lane * 8;
#pragma unroll
        for (int q = 0; q < 4; ++q) __builtin_amdgcn_global_load_lds((const unsigned*)(sp + 512 * q), (LAS unsigned*)(stF + (4 * wid + q) * 1024), 16, 0, 0);
        const bf16* vp = VT + (size_t)(h * 128 + 16 * wid + j) * MP + m0 + 8 * kq;
#pragma unroll
        for (int q = 0; q < 2; ++q) __builtin_amdgcn_global_load_lds((const unsigned*)(vp + 32 * q), (LAS unsigned*)(vtF + (2 * wid + q) * 1024), 16, 0, 0); }
    const size_t row = (size_t)(m0 + t0 + j);
    f32x4 gg[4]; u32x2 zg[4];
#pragma unroll
    for (int vt = 0; vt < 4; ++vt) { const int v = 64 * vh + 16 * vt + 4 * kq; gg[vt] = *(const f32x4*)(hgg + h * 128 + v); zg[vt] = *(const u32x2*)(zbuf + row * ZC + 1024 + h * 128 + v); }
    float lfa[8], lfb[8]; float ra = 0.f, rb = 0.f;
#pragma unroll
    for (int i = 0; i < 8; ++i) { const f16x2_t hv = __builtin_bit_cast(f16x2_t, lw[i]); lfa[i] = (float)hv[0]; lfb[i] = (float)hv[1]; ra += lfa[i]; rb += lfb[i]; }
    *(LAS f32x2_t*)(segsum + seg * 128 + k0) = (f32x2_t){ra, rb};
    LBAR();
    float offa = 0.f, offb = 0.f, bma = 0.f, bmb = 0.f;
#pragma unroll
    for (int s = 0; s < 8; ++s) { const f32x2_t sv = *(const LAS f32x2_t*)(segsum + s * 128 + k0); if (s < seg) { offa += sv[0]; offb += sv[1]; } if (s < 4) { bma += sv[0]; bmb += sv[1]; } }
    float ba = offa, bb = offb;
#pragma unroll
    for (int i = 0; i < 8; ++i) { ba += lfa[i]; bb += lfb[i]; const int t = 8 * seg + i; const float qa = bflo(qw[i]), qb_ = bfhi(qw[i]);
        const float da = fminf(fmaxf(ba - bma, -80.f), 80.f), db = fminf(fmaxf(bb - bmb, -80.f), 80.f);
        *(LAS unsigned*)(qbL + t * PITCH + 4 * kp) = pkbf(qa * __expf(da), qb_ * __expf(db));
        *(LAS unsigned*)(kbL + t * PITCH + 4 * kp) = pkbf((1.f - __expf(lfa[i])) * __expf(-da), (1.f - __expf(lfb[i])) * __expf(-db));
        *(LAS unsigned*)(qsL + t * PITCH + 4 * kp) = pkbf(qa * __expf(ba), qb_ * __expf(bb)); }
    asm volatile("s_waitcnt vmcnt(0)" ::: "memory");
    LBAR();
    if (nxt < 1024) hgrn_c_loads(zbuf, nxt, tid, lw, qw);
    f32x4 acc[4];
#pragma unroll
    for (int vt = 0; vt < 4; ++vt) acc[vt] = (f32x4){0.f, 0.f, 0.f, 0.f};
    {
#pragma unroll
        for (int ks = 0; ks < 4; ++ks) { const bf16x8 bq = *(const LAS bf16x8*)(qsL + (t0 + j) * PITCH + (32 * ks + 8 * kq) * 2);
#pragma unroll
            for (int vt = 0; vt < 4; ++vt) acc[vt] = MFMA16(*(const LAS bf16x8*)(stF + ((4 * vh + vt) * 4 + ks) * 1024 + lane * 16), bq, acc[vt]); } }
#pragma unroll
    for (int sb = 0; sb < 2; ++sb) { if (sb > (tt >> 1)) break;
        const int sbase = 32 * sb, sr0 = sbase + 8 * (j >> 2) + (j & 3);
        f32x4 p0 = {0.f, 0.f, 0.f, 0.f}, p1 = {0.f, 0.f, 0.f, 0.f};
#pragma unroll
        for (int ks = 0; ks < 4; ++ks) { const bf16x8 bq = *(const LAS bf16x8*)(qbL + (t0 + j) * PITCH + (32 * ks + 8 * kq) * 2);
            p0 = MFMA16(*(const LAS bf16x8*)(kbL + sr0 * PITCH + (32 * ks + 8 * kq) * 2), bq, p0);
            p1 = MFMA16(*(const LAS bf16x8*)(kbL + (sr0 + 4) * PITCH + (32 * ks + 8 * kq) * 2), bq, p1); }
        const int t = t0 + j, sk = sbase + 8 * kq;
#pragma unroll
        for (int e = 0; e < 4; ++e) { if (sk + e > t) p0[e] = 0.f; if (sk + 4 + e > t) p1[e] = 0.f; }
        u32x4 pw; pw.x = pkbf(p0[0], p0[1]); pw.y = pkbf(p0[2], p0[3]); pw.z = pkbf(p1[0], p1[1]); pw.w = pkbf(p1[2], p1[3]);
        const bf16x8 pb = __builtin_bit_cast(bf16x8, pw);
#pragma unroll
        for (int vt = 0; vt < 4; ++vt) acc[vt] = MFMA16(*(const LAS bf16x8*)(vtF + ((4 * vh + vt) * 2 + sb) * 1024 + lane * 16), pb, acc[vt]);
    }
    float ss = 0.f;
#pragma unroll
    for (int vt = 0; vt < 4; ++vt) ss += (acc[vt][0] * acc[vt][0] + acc[vt][1] * acc[vt][1]) + (acc[vt][2] * acc[vt][2] + acc[vt][3] * acc[vt][3]);
    ss += __shfl_xor(ss, 16); ss += __shfl_xor(ss, 32);
    if (kq == 0) ssqL[(vh * 4 + tt) * 16 + j] = ss;
    LBAR();
    const float tot = ssqL[tt * 16 + j] + ssqL[(4 + tt) * 16 + j];
    const float rinv = rsqrtf(tot * (1.0f / 128.0f) + EPS);
#pragma unroll
    for (int vt = 0; vt < 4; ++vt) { const int v = 64 * vh + 16 * vt + 4 * kq;
        u32x2 w; w.x = pkbf(acc[vt][0] * rinv * gg[vt][0] * bflo(zg[vt].x), acc[vt][1] * rinv * gg[vt][1] * bfhi(zg[vt].x)); w.y = pkbf(acc[vt][2] * rinv * gg[vt][2] * bflo(zg[vt].y), acc[vt][3] * rinv * gg[vt][3] * bfhi(zg[vt].y));
        *(u32x2*)(ohg + row * 512 + h * 128 + v) = w; }
    LBAR();
}

__device__ __forceinline__ float xrow16_max(float x) {
    auto s = __builtin_amdgcn_permlane16_swap(__float_as_uint(x), __float_as_uint(x), false, false); x = fmaxf(__uint_as_float(s[0]), __uint_as_float(s[1]));
    auto t = __builtin_amdgcn_permlane32_swap(__float_as_uint(x), __float_as_uint(x), false, false); return fmaxf(__uint_as_float(t[0]), __uint_as_float(t[1])); }
__device__ __forceinline__ float xrow16_sum(float x) {
    auto s = __builtin_amdgcn_permlane16_swap(__float_as_uint(x), __float_as_uint(x), false, false); x = __uint_as_float(s[0]) + __uint_as_float(s[1]);
    auto t = __builtin_amdgcn_permlane32_swap(__float_as_uint(x), __float_as_uint(x), false, false); return __uint_as_float(t[0]) + __uint_as_float(t[1]); }
__device__ __forceinline__ void attn_unit(LAS unsigned char* lds, const bf16* zbuf, const bf16* VT, bf16* og, float* lse, int bh, int g, int r, int qt, bool second) {
    int tid = threadIdx.x; asm volatile("" : "+v"(tid));
    const int lane = tid & 63, wid = __builtin_amdgcn_readfirstlane(tid >> 6), j = lane & 15, rq = lane >> 4;
    const int bl = bh >> 2, h = bh & 3;
    const int ld = 2 * g, per = 4096 >> ld, M0 = 128 * qt, gblk0 = 4 * qt - 4;
    {
        const int kbs = second ? 4 + (wid >> 1) : wid; const bool doK = !second || !(wid & 1), doV = !second || (wid & 1);
        const int mkb = M0 - 128 + 32 * kbs;
        LAS unsigned char* slot = lds + ((gblk0 + kbs) & 7) * 16384;
        if (mkb + 31 >= 0) {
            const bf16* kbase = zbuf + (size_t)(bl * 4096) * ZC + 3072 + g * 512 + h * 128 + 8 * rq;
            const bf16* vbase = VT + (size_t)(512 + g * 512 + h * 128 + j) * MP + bl * 4096 + r * per;
            const int mk0 = mkb + 8 * (j >> 2) + (j & 3), mk1 = mk0 + 4;
            const int mk0c = min(max(mk0, 0), per - 1), mk1c = min(max(mk1, 0), per - 1);
            const bf16* k0p = kbase + (size_t)((mk0c << ld) + r) * ZC; const bf16* k1p = kbase + (size_t)((mk1c << ld) + r) * ZC;
            const bf16* vp = vbase + min(max(mkb + 8 * rq, 0), per - 8);
            if (doK) {
#pragma unroll
                for (int ks = 0; ks < 4; ++ks) {
                    __builtin_amdgcn_global_load_lds((const unsigned*)(k0p + 32 * ks), (LAS unsigned*)(slot + ks * 1024), 16, 0, 0);
                    __builtin_amdgcn_global_load_lds((const unsigned*)(k1p + 32 * ks), (LAS unsigned*)(slot + 4096 + ks * 1024), 16, 0, 0); } }
            if (doV) {
#pragma unroll
                for (int dt = 0; dt < 8; ++dt) __builtin_amdgcn_global_load_lds((const unsigned*)(vp + (size_t)dt * 16 * MP), (LAS unsigned*)(slot + 8192 + dt * 1024), 16, 0, 0); }
        }
    }
    const int mqj = M0 + 16 * wid + j;
    const size_t qrow = (size_t)(bl * 4096 + (mqj << ld) + r);
    const bf16* qp = zbuf + qrow * ZC + 1536 + g * 512 + h * 128 + 8 * rq;
    bf16x8 qf[4];
#pragma unroll
    for (int ks = 0; ks < 4; ++ks) qf[ks] = *(const bf16x8*)(qp + 32 * ks);
    f32x4 acc[8];
#pragma unroll
    for (int dt = 0; dt < 8; ++dt) acc[dt] = (f32x4){0.f, 0.f, 0.f, 0.f};
    float mrun = -1e30f, lrun = 0.f;
    const int klo = max(mqj - 128, 0); const unsigned kspan = (unsigned)(mqj - klo); const int mq0w = M0 + 16 * wid;
    asm volatile("s_waitcnt vmcnt(0)" ::: "memory");
    __syncthreads();
    const int kb0 = (16 * wid) >> 5, kb1 = (16 * wid + 143) >> 5;
    for (int kb = kb0; kb <= kb1; ++kb) {
        const int mkb = M0 - 128 + 32 * kb;
        if (mkb + 31 < 0) continue;
        const LAS unsigned char* mine = lds + ((gblk0 + kb) & 7) * 16384 + lane * 16;
        bf16x8 k0[4], k1[4], vf[8];
#pragma unroll
        for (int ks = 0; ks < 4; ++ks) { k0[ks] = *(const LAS bf16x8*)(mine + ks * 1024); k1[ks] = *(const LAS bf16x8*)(mine + 4096 + ks * 1024); }
#pragma unroll
        for (int dt = 0; dt < 8; ++dt) vf[dt] = *(const LAS bf16x8*)(mine + 8192 + dt * 1024);
        f32x4 s0 = {0.f, 0.f, 0.f, 0.f}, s1 = {0.f, 0.f, 0.f, 0.f};
#pragma unroll
        for (int ks = 0; ks < 4; ++ks) { s0 = MFMA16(k0[ks], qf[ks], s0); s1 = MFMA16(k1[ks], qf[ks], s1); }
        const int kb_ = mkb + 8 * rq - klo; float bm = -1e30f;
        if (!(mkb >= mq0w - 113 && mkb + 31 <= mq0w && mkb >= 0)) {
#pragma unroll
            for (int e = 0; e < 4; ++e) {
                if ((unsigned)(kb_ + e) > kspan) s0[e] = -1e30f;
                if ((unsigned)(kb_ + 4 + e) > kspan) s1[e] = -1e30f; } }
#pragma unroll
        for (int e = 0; e < 4; ++e) bm = fmaxf(bm, fmaxf(s0[e], s1[e]));
        bm = xrow16_max(bm);
        if (__builtin_amdgcn_ballot_w64(bm > mrun + 8.0f) != 0ull) {
            const float mn = fmaxf(mrun, bm), alpha = __builtin_amdgcn_exp2f(mrun - mn); mrun = mn; lrun *= alpha;
#pragma unroll
            for (int dt = 0; dt < 8; ++dt) acc[dt] = acc[dt] * alpha;
        }
        float ps = 0.f;
#pragma unroll
        for (int e = 0; e < 4; ++e) { s0[e] = __builtin_amdgcn_exp2f(s0[e] - mrun); s1[e] = __builtin_amdgcn_exp2f(s1[e] - mrun); ps += s0[e] + s1[e]; }
        lrun += ps;
        u32x4 pw; pw.x = pkbf(s0[0], s0[1]); pw.y = pkbf(s0[2], s0[3]); pw.z = pkbf(s1[0], s1[1]); pw.w = pkbf(s1[2], s1[3]);
        const bf16x8 pb = __builtin_bit_cast(bf16x8, pw);
#pragma unroll
        for (int dt = 0; dt < 8; ++dt) acc[dt] = MFMA16(vf[dt], pb, acc[dt]);
    }
    lrun = xrow16_sum(lrun);
    const float inv = 1.0f / lrun;
    bf16* op = og + qrow * 512 + h * 128 + 4 * rq;
#pragma unroll
    for (int dt = 0; dt < 8; ++dt) { u32x2 w; w.x = pkbf(acc[dt][0] * inv, acc[dt][1] * inv); w.y = pkbf(acc[dt][2] * inv, acc[dt][3] * inv); *(u32x2*)(op + 16 * dt) = w; }
    if (rq == 0) lse[qrow * 4 + h] = mrun + __builtin_amdgcn_logf(lrun);
    __syncthreads();
}
__device__ __forceinline__ void attn_merge(const bf16* og0, const bf16* og1, const bf16* og2, const float* lse0, const float* lse1, const float* lse2, bf16* oatt, int gid, int gstride) {
    asm volatile("" : "+v"(gid));
    for (int id = gid; id < MP * 64; id += gstride) {
        const int row = id >> 6, hc = id & 63, h = hc >> 4;
        const float l0 = lse0[row * 4 + h], l1 = lse1[row * 4 + h], l2 = lse2[row * 4 + h];
        const float mx = fmaxf(l0, fmaxf(l1, l2));
        float w0 = __builtin_amdgcn_exp2f(l0 - mx), w1 = __builtin_amdgcn_exp2f(l1 - mx), w2 = __builtin_amdgcn_exp2f(l2 - mx);
        const float inv = 1.0f / (w0 + w1 + w2); w0 *= inv; w1 *= inv; w2 *= inv;
        const size_t off = (size_t)row * 512 + hc * 8;
        const u32x4 a = *(const u32x4*)(og0 + off), b = *(const u32x4*)(og1 + off), c = *(const u32x4*)(og2 + off);
        u32x4 o;
        o.x = pkbf(w0 * bflo(a.x) + w1 * bflo(b.x) + w2 * bflo(c.x), w0 * bfhi(a.x) + w1 * bfhi(b.x) + w2 * bfhi(c.x));
        o.y = pkbf(w0 * bflo(a.y) + w1 * bflo(b.y) + w2 * bflo(c.y), w0 * bfhi(a.y) + w1 * bfhi(b.y) + w2 * bfhi(c.y));
        o.z = pkbf(w0 * bflo(a.z) + w1 * bflo(b.z) + w2 * bflo(c.z), w0 * bfhi(a.z) + w1 * bfhi(b.z) + w2 * bfhi(c.z));
        o.w = pkbf(w0 * bflo(a.w) + w1 * bflo(b.w) + w2 * bflo(c.w), w0 * bfhi(a.w) + w1 * bfhi(b.w) + w2 * bfhi(c.w));
        *(u32x4*)(oatt + off) = o;
    }
}

struct Args { const float* in[12]; float* out; unsigned char* ws; };
__global__ void __launch_bounds__(512, 2) hyb_fwd(Args a) {
    extern __shared__ __attribute__((aligned(16))) unsigned char lds_raw[];
    LAS unsigned char* lds = (LAS unsigned char*)lds_raw;
    cg::grid_group grid = cg::this_grid();
    const int tid = threadIdx.x, lane = tid & 63, wid = __builtin_amdgcn_readfirstlane(tid >> 6);
    const int G = gridDim.x, bx = blockIdx.x, gw = bx * 8 + wid, NGW = G * 8;
    const float* x = a.in[0]; const float* norm1_g = a.in[1]; const float* w_in = a.in[2]; const float* hg_lb = a.in[3]; const float* hg_norm_g = a.in[4];
    const float* w_a = a.in[5]; const float* w_b = a.in[6]; const float* w_out = a.in[7]; const float* norm2_g = a.in[8]; const float* w_up = a.in[9]; const float* w_down = a.in[10]; const float* gfinal = a.in[11];
    unsigned char* ws = a.ws;
    float* ssq = (float*)(ws + WS_SSQ); float* lbv = (float*)(ws + WS_LB); float* rc = (float*)(ws + WS_COS); float* rs = (float*)(ws + WS_SIN);
    bf16* W = (bf16*)(ws + WS_W); bf16* xb = (bf16*)(ws + WS_XB); bf16* ST = (bf16*)((unsigned char*)a.out + 64 * MiB);     bf16* zbuf = (bf16*)(ws + WS_Z);
    bf16* tmp = (bf16*)(ws + WS_Z); bf16* ybuf = (bf16*)(ws + WS_Z + 64 * MiB); bf16* ubuf = (bf16*)(ws + WS_Z);
    bf16* gt = (bf16*)(ws + WS_GT); bf16* VT = (bf16*)(ws + WS_VT); bf16* ohg = (bf16*)(ws + WS_OHG); bf16* oatt = (bf16*)(ws + WS_OATT);
    bf16* KVT = (bf16*)(ws + WS_KVT); float* dec = (float*)(ws + WS_DEC);
    bf16* og2 = (bf16*)(ws + WS_OG2); float* lsev = (float*)(ws + WS_LSE);
    unsigned* barw = (unsigned*)(ws + WS_BAR);
    volatile LAS unsigned* bst = (volatile LAS unsigned*)(lds + LDS_BYTES - 64);
    if (tid < 2) bst[tid] = 0u;
    for (int i = bx * 512 + tid; i < XCD_BAR_WORDS; i += G * 512) barw[i] = 0u;

#define GSYNC() do { for (int s_ = 0; s_ < REP_SYNC; ++s_) xcd_barrier(xbar); } while (0)
    for (int rep0_ = 0; rep0_ < REP_PRO; ++rep0_)
    {
        LAS float* scr = (LAS float*)(lds + wid * 16384);
        for (int it = gw; it < 2 * 9472; it += NGW) {
            const int l = it >= 9472 ? 1 : 0; int r = it - l * 9472;
            const float* src; int ldw, K, k0, nsrc0, ndst0; bf16* dst; const float* gain = nullptr; bf16* wl = W + (size_t)l * L_ELEMS;
            if (r < 3328) { const int nb = r % 208, kb = r / 208, n0 = nb * 32; src = w_in + (size_t)l * 1024 * NIN; ldw = NIN; K = 1024; k0 = kb * 64; nsrc0 = n0 < 1024 ? n0 : (n0 < 4608 ? n0 + 512 : n0 + 2048); dst = wl + W_MAIN; ndst0 = n0; gain = norm1_g + l * 1024; }
            else if ((r -= 3328) < 1024) { const int nb = r % 64, kb = r / 64, n0 = nb * 32; src = w_in + (size_t)l * 1024 * NIN; ldw = NIN; K = 1024; k0 = kb * 64; nsrc0 = n0 < 512 ? 1024 + n0 : 4608 + n0; dst = wl + W_V; ndst0 = n0; gain = norm1_g + l * 1024; }
            else if ((r -= 1024) < 256) { const int nb = r % 32, kb = r / 32; src = w_a + (size_t)l * 512 * 1024; ldw = 1024; K = 512; k0 = kb * 64; nsrc0 = nb * 32; dst = wl + W_A; ndst0 = nb * 32; }
            else if ((r -= 256) < 256) { const int nb = r % 32, kb = r / 32; src = w_b + (size_t)l * 512 * 1024; ldw = 1024; K = 512; k0 = kb * 64; nsrc0 = nb * 32; dst = wl + W_B; ndst0 = nb * 32; }
            else if ((r -= 256) < 512) { const int nb = r % 32, kb = r / 32; src = w_out + (size_t)l * 1024 * 1024; ldw = 1024; K = 1024; k0 = kb * 64; nsrc0 = nb * 32; dst = wl + W_OUT; ndst0 = nb * 32; }
            else if ((r -= 512) < 2048) { const int nb = r % 128, kb = r / 128; src = w_up + (size_t)l * 1024 * 4096; ldw = 4096; K = 1024; k0 = kb * 64; nsrc0 = nb * 32; dst = wl + W_UP; ndst0 = nb * 32; gain = norm2_g + l * 1024; }
            else { r -= 2048; const int nb = r % 32, kb = r / 32; src = w_down + (size_t)l * 4096 * 1024; ldw = 1024; K = 4096; k0 = kb * 64; nsrc0 = nb * 32; dst = wl + W_DOWN; ndst0 = nb * 32; }
            tr_item(src, ldw, K, k0, nsrc0, dst, ndst0, gain, scr, lane);
        }
        const int gt_ = bx * 512 + tid, GT = G * 512;
        for (int idx = gt_; idx < 16; idx += GT) rc[idx] = powf(500000.0f, -(float)idx / 16.0f);
        for (int idx = gt_; idx < 1024; idx += GT) { const int k = idx & 511; lbv[idx] = idx < 512 ? 0.f : sigm(hg_lb[512 + k] - hg_lb[k]); }
        for (int m = gw; m < MP; m += NGW) xb_row(x + (size_t)m * DM, xb + (size_t)m * DM, ssq + (size_t)m * 16, lane);
    }
    grid.sync();
    const XcdBarrier xbar = xcd_barrier_post(barw, bst);

    for (int pass = 0; pass < NPASS; ++pass) {
        const size_t rb = (size_t)pass * MP;
        float* xres = a.out + rb * DM; const float* xin0 = x + rb * DM; float* ssqp = ssq + (size_t)pass * 5 * MP * 16;
        for (int l = 0; l < 2; ++l) {
            const bf16* wl = W + (size_t)l * L_ELEMS;
            const float* ssq_n1 = ssqp + (size_t)(l == 0 ? 0 : 2) * MP * 16; float* ssq_n2 = ssqp + (size_t)(l == 0 ? 1 : 3) * MP * 16; float* ssq_nx = ssqp + (size_t)(l == 0 ? 2 : 4) * MP * 16;
            for (int rep_ = 0; rep_ < REP_G1; ++rep_) {
            for (int call = 0; call < 3; ++call) {
                const int bld = 2 * call, Mv = call == 0 ? 1024 : 512, rowoff = call == 0 ? 0 : (call == 1 ? 1024 : 1536);
                const int cc = call == 2 ? (bx + G / 2) % G : bx;
                pg8::Gemm g{wl + W_V + (size_t)rowoff * 1024, xb, Mv, MP, 1024, bld}; pg8::StaticOrder S; S.init(Mv, MP, G, cc);
                EpiVT E{VT, ssq_n1, rowoff, bld};
                pg8::gemm_phase<EpiVT, pg8::StaticOrder, true, true>(lds, g, S, E);
            }
            {   pg8::Gemm g{xb, wl + W_MAIN, MP, NMAIN, 1024, 0}; pg8::StaticOrder S; S.init(MP, NMAIN, G, bx);
                EpiMain E{zbuf, gt, ssq_n1, lbv + l * 512, rc, rs};
                pg8::gemm_phase<EpiMain, pg8::StaticOrder, true, true>(lds, g, S, E); }
            }
            GSYNC();
            for (int rep_ = 0; rep_ < REP_HA; ++rep_) { unsigned lwA[8]; int t_ = threadIdx.x; asm volatile("" : "+v"(t_));
                if (bx < 1024) hgrn_a_loads(zbuf, bx, t_, lwA);
                for (int ch = bx; ch < 1024; ch += G) hgrn_passA(lds, zbuf, VT, KVT, dec, ch, ch + G, lwA); }
            for (int rep_ = 0; rep_ < REP_AU; ++rep_)
            for (int p_ = bx; p_ < 768; p_ += G) {
                const int bh_ = p_ / 48, q_ = p_ % 48, g_ = q_ >> 4, w_ = q_ & 15, ld_ = 2 * g_, r_ = w_ >> (4 - ld_), qt0_ = 2 * (w_ & ((16 >> ld_) - 1));
                bf16* ogp_ = g_ == 0 ? ohg : (g_ == 1 ? oatt : og2); float* lsep_ = lsev + (size_t)g_ * MP * 4;
                attn_unit(lds, zbuf, VT, ogp_, lsep_, bh_, g_, r_, qt0_, false);
                attn_unit(lds, zbuf, VT, ogp_, lsep_, bh_, g_, r_, qt0_ + 1, true); }
            GSYNC();
            int t2_ = threadIdx.x; asm volatile("" : "+v"(t2_));
            for (int rep_ = 0; rep_ < REP_ATT; ++rep_) attn_merge(ohg, oatt, og2, lsev, lsev + (size_t)MP * 4, lsev + (size_t)2 * MP * 4, oatt, bx * 512 + t2_, G * 512);
            for (int rep_ = 0; rep_ < REP_HS; ++rep_) hgrn_scan(KVT, dec, ST, bx * 512 + t2_, G * 512);
            GSYNC();
            for (int rep_ = 0; rep_ < REP_HC; ++rep_) { unsigned lwC[8], qwC[8]; int t_ = threadIdx.x; asm volatile("" : "+v"(t_));
                if (bx < 1024) hgrn_c_loads(zbuf, bx, t_, lwC, qwC);
                for (int ch = bx; ch < 1024; ch += G) hgrn_passC(lds, zbuf, VT, ST, hg_norm_g + l * 512, ohg, ch, ch + G, lwC, qwC); }
            GSYNC();
            for (int rep_ = 0; rep_ < REP_P3; ++rep_) {
                pg8::Gemm g{ohg, wl + W_A, MP, DM, 512, 0, oatt, wl + W_B}; pg8::ChainOrder S; S.init(MP, DM, G, bx); EpiGateChain E{gt, ybuf};
                pg8::gemm_phase<EpiGateChain, pg8::ChainOrder, true, true>(lds, g, S, E); }
            GSYNC();
            {   pg8::Gemm g{ybuf, wl + W_OUT, MP, DM, 1024, 0}; pg8::StaticOrder S; S.init(MP, DM, G, bx); EpiRes E{xb, ssq_n2};
                pg8::gemm_phase<EpiRes, pg8::StaticOrder, true, true>(lds, g, S, E); }
            GSYNC();
            for (int rep_ = 0; rep_ < REP_P5; ++rep_)
            {   pg8::Gemm g{xb, wl + W_UP, MP, FF, 1024, 0}; pg8::StaticOrder S; S.init(MP, FF, G, bx); EpiUp E{ubuf, ssq_n2};
                pg8::gemm_phase<EpiUp, pg8::StaticOrder, true, true>(lds, g, S, E); }
            GSYNC();
            {   pg8::Gemm g{ubuf, wl + W_DOWN, MP, DM, FF, 0}; pg8::StaticOrder S; S.init(MP, DM, G, bx); EpiRes E{xb, ssq_nx};
                pg8::gemm_phase<EpiRes, pg8::StaticOrder, true, true>(lds, g, S, E); }
            GSYNC();
        }
        int lane2 = lane; asm volatile("" : "+v"(lane2));
        for (int m = gw; m < MP; m += NGW) final_row(xb + (size_t)m * DM, xres + (size_t)m * DM, gfinal, lane2);
        if (pass + 1 < NPASS) {
            for (int m = gw; m < MP; m += NGW) xb_row(x + (rb + MP + m) * DM, xb + (size_t)m * DM, ssq + ((size_t)(pass + 1) * 5 * MP + m) * 16, lane2);
            GSYNC();
        }
    }
}

extern "C" void kernel_launch(void* const* d_in, const int* in_sizes, int n_in, void* d_out, int out_size, void* d_ws, size_t ws_size, hipStream_t stream) {
    static int grid = 0;
    if (grid == 0) {
        if (n_in != 12 || ws_size < WS_END) { fprintf(stderr, "kernel_launch: need 12 inputs and >= %zu bytes of workspace (got %d, %zu)\n", (size_t)WS_END, n_in, ws_size); grid = -1; return; }
        int dev = 0, cus = 0, per_cu = 0;
        hipGetDevice(&dev); hipDeviceGetAttribute(&cus, hipDeviceAttributeMultiprocessorCount, dev);
        hipFuncSetAttribute((const void*)hyb_fwd, hipFuncAttributeMaxDynamicSharedMemorySize, LDS_BYTES);
        hipOccupancyMaxActiveBlocksPerMultiprocessor(&per_cu, (const void*)hyb_fwd, 512, LDS_BYTES);
        if (per_cu < 1) per_cu = 1;
        grid = cus * per_cu;
        (void)hipGetLastError();
    }
    if (grid < 0) return;
    Args a{};
    for (int i = 0; i < 12; ++i) a.in[i] = (const float*)d_in[i];
    a.out = (float*)d_out; a.ws = (unsigned char*)d_ws;
    void* args[] = {&a};
    hipError_t e = hipLaunchCooperativeKernel((const void*)hyb_fwd, dim3(grid), dim3(512), args, LDS_BYTES, stream);
    if (e != hipSuccess) fprintf(stderr, "cooperative launch failed: %s (grid %d)\n", hipGetErrorString(e), grid);
}
```

```cpp
#include <hip/hip_runtime.h>
#include <hip/hip_cooperative_groups.h>
#include <cstdio>
#include <cstdint>
namespace cg = cooperative_groups;
namespace pg8 {
#define PG8_LAS __attribute__((address_space(3)))
typedef unsigned short bf16_t;
typedef short bf16x8 __attribute__((ext_vector_type(8)));
typedef float f32x4 __attribute__((ext_vector_type(4)));
typedef unsigned u32x4 __attribute__((ext_vector_type(4)));
constexpr int BM = 256, BK = 64, HALF = 128, HTB = HALF * BK * 2  , STAGE_BYTES = 8 * HTB, NXCD = 8, WGM = 4;

__host__ __device__ __forceinline__ int lds_byte(int r, int c) { const int st = (r >> 4) * 2 + (c >> 5), rr = r & 15, cc = c & 31, ob = rr * 64 + cc * 2; return st * 1024 + (ob ^ (((ob >> 9) & 1) << 5)); }
__host__ __device__ __forceinline__ void stage_rc(int b, int& R, int& C) { const int st = b / 1024, sb = b % 1024, swz = sb ^ (((sb >> 9) & 1) << 5); R = (st >> 1) * 16 + swz / 64; C = (st & 1) * 32 + (swz % 64) / 2; }
__host__ __device__ __forceinline__ int perm32(int rho) { const int n = rho >> 4, i = rho & 15; return 8 * (i >> 2) + 4 * n + (i & 3); }

struct Unit { int pm, pn, sel; };
struct Gemm { const bf16_t* A; const bf16_t* Bt; int M, N, K; int bld; const bf16_t* A2; const bf16_t* Bt2; };
__device__ __forceinline__ size_t btile_off(int pn, int bld, int K) { const int p0 = pn * 256, b = p0 >> 12, w = p0 & 4095, sh = 12 - bld, r = w >> sh, m0 = w & ((1 << sh) - 1); return (size_t)(b * 4096 + r + (m0 << bld)) * (size_t)K * 2; }

struct StaticOrder {
    int nM, nN, nwg, G, c;
    __host__ __device__ void init(int M, int N, int G_, int c_) { nM = M / BM; nN = N / BM; nwg = nM * nN; G = G_; c = c_; }
    __host__ __device__ bool next(int i, Unit& u) const {
        const long L = (long)i * G + c; if (L >= nwg) return false;
        int wgid = (int)L; { const int q = nwg / NXCD, r = nwg % NXCD, xcd = wgid % NXCD, off = wgid / NXCD; wgid = (xcd < r ? xcd * (q + 1) : r * (q + 1) + (xcd - r) * q) + off; }
        const int nig = WGM * nN, gid = wgid / nig, fm = gid * WGM, gsz = (nM - fm) < WGM ? (nM - fm) : WGM;
        u.pm = fm + ((wgid % nig) % gsz); u.pn = (wgid % nig) / gsz; u.sel = 0; return true;
    }
    __device__ __forceinline__ void a_ready(const Unit&) const {}
    __device__ __forceinline__ void done(const Unit&) const {}
};

struct ChainOrder { StaticOrder base;
    __device__ void init(int M, int N, int G_, int c_) { base.init(M, N, G_, c_); }
    __device__ bool next(int i, Unit& u) const { if (!base.next(i >> 1, u)) return false; u.sel = i & 1; return true; }
    __device__ __forceinline__ void a_ready(const Unit&) const {}
    __device__ __forceinline__ void done(const Unit&) const {} };
__device__ __forceinline__ unsigned cvt_pk_bf16(float lo, float hi) { unsigned r; asm volatile("v_cvt_pk_bf16_f32 %0, %1, %2" : "=v"(r) : "v"(lo), "v"(hi)); return r; }
template <class Epi, class Sched, bool ALIGN_EPI = false, bool SP2 = false>
__device__ __forceinline__ void gemm_phase(PG8_LAS unsigned char* lds, const Gemm g, const Sched& S, const Epi& E) {
    int tid_ = threadIdx.x; asm volatile("" : "+v"(tid_));
    const int tid = tid_, wid = __builtin_amdgcn_readfirstlane(tid >> 6), lane = tid & 63, wr = wid >> 2, wc = wid & 3, fr = lane & 15, fq = lane >> 4;
    const int K = g.K, nt = K / BK;
    unsigned voffA[2], voffB[2];
#pragma unroll
    for (int i = 0; i < 2; ++i) { int R, C; stage_rc(tid * 16 + i * 8192, R, C); const int Rb = Epi::PERM ? ((R & ~31) + perm32(R & 31)) : R;
        voffA[i] = (unsigned)(R * K + C) * 2u; voffB[i] = (unsigned)((Rb << g.bld) * K + C) * 2u; }
    const size_t kstep = (size_t)(BK * 2);
    const size_t hstep = (size_t)HALF * K * 2;
    const size_t tstep = 2 * hstep; const size_t hstepB = hstep << g.bld;
    const unsigned ldsw = (unsigned)wid * 1024u;
    const int aoff = lds_byte(wr * 64 + fr, fq * 8), boff = lds_byte(wc * 32 + fr, fq * 8);
#define PG8_SA(b, h) (((b) * 2 + (h)) * HTB)
#define PG8_SB(b, h) ((4 + (b) * 2 + (h)) * HTB)
#define PG8_STAGE(bufoff, gbase, voff) do { _Pragma("unroll") for (int _i = 0; _i < 2; ++_i) \
        __builtin_amdgcn_global_load_lds((const unsigned*)((const char*)(gbase) + (voff)[_i]), (PG8_LAS unsigned*)(lds + (bufoff) + ldsw + _i * 8192), 16, 0, 0); } while (0)
#define PG8_LDA(dst, b, h) do { _Pragma("unroll") for (int m = 0; m < 4; ++m) _Pragma("unroll") for (int k = 0; k < 2; ++k) dst[m][k] = *(const PG8_LAS bf16x8*)(lds + PG8_SA(b, h) + aoff + m * 2048 + k * 1024); } while (0)
#define PG8_LDB(dst, b, h) do { _Pragma("unroll") for (int n = 0; n < 2; ++n) _Pragma("unroll") for (int k = 0; k < 2; ++k) dst[n][k] = *(const PG8_LAS bf16x8*)(lds + PG8_SB(b, h) + boff + n * 2048 + k * 1024); } while (0)
#define PG8_MMA(ai, bj, At, Bt) do { __builtin_amdgcn_s_setprio(1); _Pragma("unroll") for (int m = 0; m < 4; ++m) _Pragma("unroll") for (int n = 0; n < 2; ++n) _Pragma("unroll") for (int k = 0; k < 2; ++k) \
        acc[ai][bj][m][n] = __builtin_amdgcn_mfma_f32_16x16x32_bf16(Bt[n][k], At[m][k], acc[ai][bj][m][n], 0, 0, 0); __builtin_amdgcn_s_setprio(0); } while (0)
#define PG8_WAIT_V(n) asm volatile("s_waitcnt vmcnt(" #n ")" ::: "memory")
#define PG8_WAIT_L(n) asm volatile("s_waitcnt lgkmcnt(" #n ")" ::: "memory")
#define PG8_BAR __builtin_amdgcn_s_barrier()
#define PG8_SCHED __builtin_amdgcn_sched_barrier(0)
    Unit cur, nxt; int ui = 0;
    if (!S.next(0, cur)) return;
    f32x4 acc[2][2][4][2];
#pragma unroll
    for (int a = 0; a < 2; ++a)
#pragma unroll
        for (int b = 0; b < 2; ++b)
#pragma unroll
            for (int m = 0; m < 4; ++m)
#pragma unroll
                for (int n = 0; n < 2; ++n) acc[a][b][m][n] = (f32x4){0.f, 0.f, 0.f, 0.f};
    bf16x8 At[4][2], B0[2][2], B1[2][2];
    const char* cA = (const char*)(cur.sel ? g.A2 : g.A) + (size_t)cur.pm * tstep; const char* cB = (const char*)(cur.sel ? g.Bt2 : g.Bt) + btile_off(cur.pn, g.bld, K);
    S.a_ready(cur);
    if constexpr (SP2) {
        PG8_STAGE(PG8_SB(0, 0), cB, voffB); PG8_STAGE(PG8_SB(0, 1), cB + hstepB, voffB); PG8_STAGE(PG8_SA(0, 0), cA, voffA); PG8_STAGE(PG8_SA(0, 1), cA + hstep, voffA);
        if (wr == 1) PG8_BAR;
        PG8_WAIT_V(2); PG8_BAR;
        PG8_STAGE(PG8_SB(1, 0), cB + kstep, voffB); PG8_STAGE(PG8_SA(1, 0), cA + kstep, voffA); PG8_STAGE(PG8_SB(1, 1), cB + hstepB + kstep, voffB);
        PG8_WAIT_V(6); PG8_BAR;
    } else {
        PG8_STAGE(PG8_SB(0, 0), cB, voffB); PG8_STAGE(PG8_SA(0, 0), cA, voffA); PG8_STAGE(PG8_SB(0, 1), cB + hstepB, voffB); PG8_STAGE(PG8_SA(0, 1), cA + hstep, voffA);
        if (wr == 1) PG8_BAR;
        PG8_WAIT_V(4); PG8_BAR;
        PG8_STAGE(PG8_SB(1, 0), cB + kstep, voffB); PG8_STAGE(PG8_SA(1, 0), cA + kstep, voffA); PG8_STAGE(PG8_SB(1, 1), cB + hstepB + kstep, voffB);
        PG8_WAIT_V(6); PG8_BAR;
    }
    for (;;) {
        const bool has_next = S.next(ui + 1, nxt);
        const char* nA = has_next ? (const char*)(nxt.sel ? g.A2 : g.A) + (size_t)nxt.pm * tstep : cA; const char* nB = has_next ? (const char*)(nxt.sel ? g.Bt2 : g.Bt) + btile_off(nxt.pn, g.bld, K) : cB;
        for (int t = 0; t < nt; t += 2) {
            const bool last = (t == nt - 2);
            const char* a1 = cA + (size_t)(t + 1) * kstep;
            const char* a2 = last ? nA : cA + (size_t)(t + 2) * kstep; const char* b2 = last ? nB : cB + (size_t)(t + 2) * kstep;
            const char* a3 = a2 + kstep; const char* b3 = b2 + kstep;
            if (last && has_next) S.a_ready(nxt);
            if constexpr (SP2) {
            PG8_LDB(B0, 0, 0); PG8_LDB(B1, 0, 1); PG8_SCHED; PG8_LDA(At, 0, 0); PG8_STAGE(PG8_SA(1, 1), a1 + hstep, voffA);
            PG8_WAIT_V(8); PG8_WAIT_L(0); PG8_BAR; PG8_MMA(0, 0, At, B0); PG8_MMA(0, 1, At, B1); PG8_BAR; PG8_SCHED;
            PG8_LDA(At, 0, 1); PG8_STAGE(PG8_SB(0, 0), b2, voffB); PG8_STAGE(PG8_SB(0, 1), b2 + hstepB, voffB); PG8_STAGE(PG8_SA(0, 0), a2, voffA);
            PG8_WAIT_V(8); PG8_WAIT_L(0); PG8_BAR; PG8_MMA(1, 0, At, B0); PG8_MMA(1, 1, At, B1); PG8_BAR; PG8_SCHED;
            PG8_LDB(B0, 1, 0); PG8_LDB(B1, 1, 1); PG8_SCHED; PG8_LDA(At, 1, 0); PG8_STAGE(PG8_SA(0, 1), a2 + hstep, voffA);
            PG8_WAIT_V(8); PG8_WAIT_L(0); PG8_BAR; PG8_MMA(0, 0, At, B0); PG8_MMA(0, 1, At, B1); PG8_BAR; PG8_SCHED;
            PG8_LDA(At, 1, 1); PG8_STAGE(PG8_SB(1, 0), b3, voffB); PG8_STAGE(PG8_SB(1, 1), b3 + hstepB, voffB); PG8_STAGE(PG8_SA(1, 0), a3, voffA);
            PG8_WAIT_V(8); PG8_WAIT_L(0); PG8_BAR; PG8_MMA(1, 0, At, B0); PG8_MMA(1, 1, At, B1); PG8_BAR; PG8_SCHED;
            } else {
            PG8_LDB(B0, 0, 0); PG8_SCHED; PG8_LDA(At, 0, 0); PG8_STAGE(PG8_SA(1, 1), a1 + hstep, voffA);
            PG8_WAIT_L(8); PG8_BAR; PG8_WAIT_L(0); PG8_MMA(0, 0, At, B0); PG8_BAR; PG8_SCHED;
            PG8_LDB(B1, 0, 1); PG8_STAGE(PG8_SB(0, 0), b2, voffB);
            PG8_BAR; PG8_WAIT_L(0); PG8_MMA(0, 1, At, B1); PG8_BAR;
            PG8_LDA(At, 0, 1); PG8_STAGE(PG8_SA(0, 0), a2, voffA);
            PG8_BAR; PG8_WAIT_L(0); PG8_MMA(1, 0, At, B0); PG8_BAR; PG8_SCHED;
            PG8_STAGE(PG8_SB(0, 1), b2 + hstepB, voffB);
            PG8_WAIT_V(6); PG8_BAR; PG8_MMA(1, 1, At, B1); PG8_BAR;
            PG8_LDB(B0, 1, 0); PG8_SCHED; PG8_LDA(At, 1, 0); PG8_STAGE(PG8_SA(0, 1), a2 + hstep, voffA);
            PG8_WAIT_L(8); PG8_BAR; PG8_WAIT_L(0); PG8_MMA(0, 0, At, B0); PG8_BAR; PG8_SCHED;
            PG8_LDB(B1, 1, 1); PG8_STAGE(PG8_SB(1, 0), b3, voffB);
            PG8_BAR; PG8_WAIT_L(0); PG8_MMA(0, 1, At, B1); PG8_BAR;
            PG8_LDA(At, 1, 1); PG8_STAGE(PG8_SA(1, 0), a3, voffA);
            PG8_BAR; PG8_WAIT_L(0); PG8_MMA(1, 0, At, B0); PG8_BAR; PG8_SCHED;
            PG8_STAGE(PG8_SB(1, 1), b3 + hstepB, voffB);
            PG8_WAIT_V(6); PG8_BAR; PG8_MMA(1, 1, At, B1); PG8_BAR;
            }
        }
        if constexpr (ALIGN_EPI) { if (wr == 0) PG8_BAR; }
        if constexpr (!Epi::AFTER_DRAIN) { int fr_ = fr, fq_ = fq; asm volatile("" : "+v"(fr_), "+v"(fq_));
            if constexpr (Epi::CHAIN) { if (cur.sel == 0) E.mid(acc, cur, wr, wc, fr_, fq_); else E(acc, cur, wr, wc, fr_, fq_); } else E(acc, cur, wr, wc, fr_, fq_);
            S.done(cur); }
        if (!has_next) break;
        if (!(Epi::CHAIN && cur.sel == 0))
#pragma unroll
        for (int a = 0; a < 2; ++a)
#pragma unroll
            for (int b = 0; b < 2; ++b)
#pragma unroll
                for (int m = 0; m < 4; ++m)
#pragma unroll
                    for (int n = 0; n < 2; ++n) acc[a][b][m][n] = (f32x4){0.f, 0.f, 0.f, 0.f};
        cur = nxt; cA = nA; cB = nB; ++ui;
        if constexpr (ALIGN_EPI) { if (wr == 1) PG8_BAR; }
    }
    PG8_WAIT_V(0);
    if constexpr (!ALIGN_EPI) { if (wr == 0) PG8_BAR; }
    PG8_BAR;
    if constexpr (Epi::AFTER_DRAIN) { E.fused(acc, cur, wr, wc, fr, fq, lds, wid, lane); S.done(cur); }
#undef PG8_SA
#undef PG8_SB
#undef PG8_STAGE
#undef PG8_LDA
#undef PG8_LDB
#undef PG8_MMA
#undef PG8_WAIT_V
#undef PG8_WAIT_L
#undef PG8_BAR
#undef PG8_SCHED
}
}

#ifndef REP_SYNC
#define REP_SYNC 1
#endif
#ifndef REP_PRO
#define REP_PRO 1
#endif
#ifndef REP_P3
#define REP_P3 1
#endif
#ifndef REP_AU
#define REP_AU 1
#endif
#ifndef REP_HA
#define REP_HA 1
#endif
#ifndef REP_HS
#define REP_HS 1
#endif
#ifndef REP_HC
#define REP_HC 1
#endif
#ifndef REP_G1
#define REP_G1 1
#endif
#ifndef REP_ATT
#define REP_ATT 1
#endif
#ifndef REP_HG
#define REP_HG 1
#endif
#ifndef REP_P5
#define REP_P5 1
#endif
#define LAS __attribute__((address_space(3)))
typedef unsigned short bf16;
typedef pg8::bf16x8 bf16x8;
typedef pg8::f32x4 f32x4;
typedef unsigned u32x4 __attribute__((ext_vector_type(4)));
typedef unsigned u32x2 __attribute__((ext_vector_type(2)));
typedef float f32x2_t __attribute__((ext_vector_type(2)));
typedef __bf16 bf16x2_t __attribute__((ext_vector_type(2)));
typedef _Float16 f16x2_t __attribute__((ext_vector_type(2)));

constexpr int DM = 1024, SEQ = 4096, GB = 4, MP = GB * SEQ, NPASS = 2, FF = 4096;
constexpr int ZC = 4608, GC = 2048;
constexpr int NMAIN = 6656, NV = 2048, NIN = 8704;
constexpr float EPS = 1e-6f;
constexpr float QSCALE = 0.08838834764831845f * 1.4426950408889634f;
constexpr size_t MiB = 1u << 20;
constexpr size_t WS_SSQ = 494 * MiB;
constexpr size_t WS_LB = 704 * 1024;
constexpr size_t WS_BAR = 768 * 1024;
constexpr size_t WS_COS = 1 * MiB, WS_SIN = 1 * MiB + 256 * 1024;
constexpr size_t WS_W = 2 * MiB;
constexpr size_t L_ELEMS = 19398656;
constexpr size_t W_MAIN = 0, W_V = 6815744, W_A = 8912896, W_B = 9437184, W_OUT = 9961472, W_UP = 11010048, W_DOWN = 15204352;
constexpr size_t WS_XB = 76 * MiB;
constexpr size_t WS_Z = 108 * MiB;
constexpr size_t WS_GT = 252 * MiB;
constexpr size_t WS_VT = 316 * MiB;
constexpr size_t WS_OHG = 380 * MiB, WS_OATT = 396 * MiB;
constexpr size_t WS_KVT = 412 * MiB;
constexpr size_t WS_DEC = 476 * MiB;
constexpr size_t WS_OG2 = 477 * MiB;
constexpr size_t WS_LSE = 493 * MiB;
constexpr size_t WS_END = 505 * MiB;
constexpr int LDS_BYTES = 147456;

__device__ __forceinline__ unsigned pkbf(float lo, float hi) { f32x2_t v = {lo, hi}; bf16x2_t b = __builtin_convertvector(v, bf16x2_t); return __builtin_bit_cast(unsigned, b); }
__device__ __forceinline__ unsigned pkh(float lo, float hi) { f16x2_t v = {(_Float16)lo, (_Float16)hi}; return __builtin_bit_cast(unsigned, v); }
__device__ __forceinline__ float bflo(unsigned w) { return __uint_as_float(w << 16); }
__device__ __forceinline__ float bfhi(unsigned w) { return __uint_as_float(w & 0xffff0000u); }
__device__ __forceinline__ float bf1(bf16 h) { return __uint_as_float((unsigned)h << 16); }
__device__ __forceinline__ float sigm(float x) { return __builtin_amdgcn_rcpf(1.f + __expf(-x)); }
__device__ __forceinline__ float wave_sum(float v) {
#pragma unroll
    for (int o = 1; o < 64; o <<= 1) v += __shfl_xor(v, o);
    return v;
}
__device__ __forceinline__ float row_rs4(const float* ssq, int row, int fq) { const f32x4 a = *(const f32x4*)(ssq + (size_t)row * 16 + 4 * fq); float s = (a[0] + a[1]) + (a[2] + a[3]);
    s += __shfl_xor(s, 16); s += __shfl_xor(s, 32); return rsqrtf(s * (1.0f / 1024.0f) + 1e-6f); }
__device__ __forceinline__ float rs4_finish(f32x4 a) { float s = (a[0] + a[1]) + (a[2] + a[3]); s += __shfl_xor(s, 16); s += __shfl_xor(s, 32); return rsqrtf(s * (1.0f / 1024.0f) + 1e-6f); }
__device__ __forceinline__ float tok_rs16(const float* ssq, int t, int fr) { float s = ssq[(size_t)t * 16 + fr];
    s += __shfl_xor(s, 1); s += __shfl_xor(s, 2); s += __shfl_xor(s, 4); s += __shfl_xor(s, 8); return rsqrtf(s * (1.0f / 1024.0f) + 1e-6f); }
#define MFMA16(a, b, c) __builtin_amdgcn_mfma_f32_16x16x32_bf16((a), (b), (c), 0, 0, 0)

using pg8::Unit;
struct EpiMain {
    static constexpr bool PERM = true, AFTER_DRAIN = false, CHAIN = false;
    bf16* Z; bf16* Gt; const float* ssq; const float* lb; const float* rc; const float* rs;
    __device__ __forceinline__ void operator()(const f32x4 (&acc)[2][2][4][2], const Unit& u, int wr, int wc, int fr, int fq) const {
        const int pn = u.pn;
        bf16* base; int ldc, colt, kind;
        if (pn < 18) { base = Z; ldc = ZC; colt = pn * 256; } else { base = Gt; ldc = GC; colt = (pn - 18) * 256; }
        kind = pn < 2 ? 0 : pn < 4 ? 1 : pn < 6 ? 2 : pn < 12 ? 3 : pn < 18 ? 4 : 2;
        const int row0 = u.pm * 256 + wr * 64 + fr, col0 = colt + wc * 32 + 8 * fq;
        const bool rope = (kind == 3 || kind == 4) && (wc == 0);
        const float sgn = (fq < 2) ? -1.f : 1.f;
        float rsv[2][4]; f32x4 pvv[2][4];
#pragma unroll
        for (int ai = 0; ai < 2; ++ai)
#pragma unroll
            for (int m = 0; m < 4; ++m) pvv[ai][m] = *(const f32x4*)(ssq + (size_t)(row0 + ai * 128 + m * 16) * 16 + 4 * fq);
#pragma unroll
        for (int ai = 0; ai < 2; ++ai)
#pragma unroll
            for (int m = 0; m < 4; ++m) rsv[ai][m] = rs4_finish(pvv[ai][m]);
        f32x4 lbq[2][2] = {{{0.f, 0.f, 0.f, 0.f}, {0.f, 0.f, 0.f, 0.f}}, {{0.f, 0.f, 0.f, 0.f}, {0.f, 0.f, 0.f, 0.f}}};
        if (kind == 1) {
#pragma unroll
            for (int bj = 0; bj < 2; ++bj) { const float* lbp = lb + (pn - 2) * 256 + bj * 128 + wc * 32 + 8 * fq; lbq[bj][0] = *(const f32x4*)lbp; lbq[bj][1] = *(const f32x4*)(lbp + 4); } }
        f32x4 i0 = {0.f, 0.f, 0.f, 0.f}, i1 = {0.f, 0.f, 0.f, 0.f};
        if (rope) { i0 = *(const f32x4*)(rc + 8 * (fq & 1)); i1 = *(const f32x4*)(rc + 8 * (fq & 1) + 4); }
        asm volatile("" ::: "memory");
#pragma unroll
        for (int ai = 0; ai < 2; ++ai)
#pragma unroll
            for (int m = 0; m < 4; ++m) {
                const int row = row0 + ai * 128 + m * 16;
                const float rsc = rsv[ai][m];
                bf16* rowp = base + (size_t)row * ldc + col0;
#pragma unroll
                for (int bj = 0; bj < 2; ++bj) {
                    float v[8];
#pragma unroll
                    for (int e = 0; e < 4; ++e) { v[e] = acc[ai][bj][m][0][e] * rsc; v[4 + e] = acc[ai][bj][m][1][e] * rsc; }
                    u32x4 w;
                    if (kind == 0) {
#pragma unroll
                        for (int e = 0; e < 8; ++e) v[e] = v[e] * sigm(v[e]);
                        w.x = pkbf(v[0], v[1]); w.y = pkbf(v[2], v[3]); w.z = pkbf(v[4], v[5]); w.w = pkbf(v[6], v[7]);
                    } else if (kind == 1) {
                        const f32x4 l0 = lbq[bj][0], l1 = lbq[bj][1];
#pragma unroll
                        for (int e = 0; e < 8; ++e) { const float lv = e < 4 ? l0[e] : l1[e - 4]; const float f = lv + (1.f - lv) * sigm(v[e]); v[e] = logf(fmaxf(f, 1e-30f)); }
                        w.x = pkh(v[0], v[1]); w.y = pkh(v[2], v[3]); w.z = pkh(v[4], v[5]); w.w = pkh(v[6], v[7]);
                    } else if (kind == 2) {
#pragma unroll
                        for (int e = 0; e < 8; ++e) v[e] = sigm(v[e]);
                        w.x = pkbf(v[0], v[1]); w.y = pkbf(v[2], v[3]); w.z = pkbf(v[4], v[5]); w.w = pkbf(v[6], v[7]);
                    } else {
                        if (rope) {
                            const float posf = (float)(row & 4095);
#pragma unroll
                            for (int e = 0; e < 8; ++e) { const float pv = __shfl_xor(v[e], 32); const float rev = __builtin_amdgcn_fractf((posf * (e < 4 ? i0[e] : i1[e - 4])) * 0.15915494309189535f);
                                const float cc = __builtin_amdgcn_cosf(rev), ss = __builtin_amdgcn_sinf(rev); v[e] = v[e] * cc + sgn * pv * ss; }
                        }
                        if (kind == 3) {
#pragma unroll
                            for (int e = 0; e < 8; ++e) v[e] *= QSCALE;
                        }
                        w.x = pkbf(v[0], v[1]); w.y = pkbf(v[2], v[3]); w.z = pkbf(v[4], v[5]); w.w = pkbf(v[6], v[7]);
                    }
                    *(u32x4*)(rowp + bj * 128) = w;
                }
            }
    }
};
struct EpiVT {
    static constexpr bool PERM = true, AFTER_DRAIN = false, CHAIN = false;
    bf16* VT; const float* ssq; int rowoff, bld;
    __device__ __forceinline__ void operator()(const f32x4 (&acc)[2][2][4][2], const Unit& u, int wr, int wc, int fr, int fq) const {
        const int row0 = rowoff + u.pm * 256 + wr * 64 + fr, p0 = u.pn * 256 + wc * 32 + 8 * fq;
        const int sh = 12 - bld;
        float scv[2][8];
#pragma unroll
        for (int bj = 0; bj < 2; ++bj)
#pragma unroll
            for (int e = 0; e < 8; ++e) { const int p = p0 + bj * 128 + e, b = p >> 12, w = p & 4095, r = w >> sh, mm = w & ((1 << sh) - 1); const int t = b * 4096 + (mm << bld) + r; scv[bj][e] = tok_rs16(ssq, t, fr); }
        asm volatile("" ::: "memory");
#pragma unroll
        for (int bj = 0; bj < 2; ++bj) {
            float sc[8];
#pragma unroll
            for (int e = 0; e < 8; ++e) sc[e] = scv[bj][e];
#pragma unroll
            for (int ai = 0; ai < 2; ++ai)
#pragma unroll
                for (int m = 0; m < 4; ++m) {
                    const f32x4 a0 = acc[ai][bj][m][0], a1 = acc[ai][bj][m][1]; u32x4 w;
                    w.x = pkbf(a0[0] * sc[0], a0[1] * sc[1]); w.y = pkbf(a0[2] * sc[2], a0[3] * sc[3]); w.z = pkbf(a1[0] * sc[4], a1[1] * sc[5]); w.w = pkbf(a1[2] * sc[6], a1[3] * sc[7]);
                    *(u32x4*)(VT + (size_t)(row0 + ai * 128 + m * 16) * MP + p0 + bj * 128) = w;
                }
        }
    }
};
struct EpiGateA {
    static constexpr bool PERM = true, AFTER_DRAIN = false, CHAIN = false;
    bf16* tmp; const bf16* Gt;
    __device__ __forceinline__ void operator()(const f32x4 (&acc)[2][2][4][2], const Unit& u, int wr, int wc, int fr, int fq) const {
        const int row0 = u.pm * 256 + wr * 64 + fr, col0 = u.pn * 256 + wc * 32 + 8 * fq;
#pragma unroll
        for (int ai = 0; ai < 2; ++ai)
#pragma unroll
            for (int m = 0; m < 4; ++m) { const int row = row0 + ai * 128 + m * 16;
#pragma unroll
                for (int bj = 0; bj < 2; ++bj) { const int col = col0 + bj * 128; const u32x4 g = *(const u32x4*)(Gt + (size_t)row * GC + col);
                    const f32x4 a0 = acc[ai][bj][m][0], a1 = acc[ai][bj][m][1]; u32x4 w;
                    w.x = pkbf(a0[0] * bflo(g.x), a0[1] * bfhi(g.x)); w.y = pkbf(a0[2] * bflo(g.y), a0[3] * bfhi(g.y));
                    w.z = pkbf(a1[0] * bflo(g.z), a1[1] * bfhi(g.z)); w.w = pkbf(a1[2] * bflo(g.w), a1[3] * bfhi(g.w));
                    *(u32x4*)(tmp + (size_t)row * DM + col) = w; } }
    }
};
struct EpiGateB {
    static constexpr bool PERM = true, AFTER_DRAIN = false, CHAIN = false;
    const bf16* tmp; const bf16* Gt; bf16* Y;
    __device__ __forceinline__ void operator()(const f32x4 (&acc)[2][2][4][2], const Unit& u, int wr, int wc, int fr, int fq) const {
        const int row0 = u.pm * 256 + wr * 64 + fr, col0 = u.pn * 256 + wc * 32 + 8 * fq;
#pragma unroll
        for (int ai = 0; ai < 2; ++ai)
#pragma unroll
            for (int m = 0; m < 4; ++m) { const int row = row0 + ai * 128 + m * 16;
#pragma unroll
                for (int bj = 0; bj < 2; ++bj) { const int col = col0 + bj * 128; const u32x4 g = *(const u32x4*)(Gt + (size_t)row * GC + 1024 + col);
                    const u32x4 t = *(const u32x4*)(tmp + (size_t)row * DM + col);
                    const f32x4 a0 = acc[ai][bj][m][0], a1 = acc[ai][bj][m][1]; u32x4 w;
                    w.x = pkbf(bflo(t.x) + a0[0] * bflo(g.x), bfhi(t.x) + a0[1] * bfhi(g.x)); w.y = pkbf(bflo(t.y) + a0[2] * bflo(g.y), bfhi(t.y) + a0[3] * bfhi(g.y));
                    w.z = pkbf(bflo(t.z) + a1[0] * bflo(g.z), bfhi(t.z) + a1[1] * bfhi(g.z)); w.w = pkbf(bflo(t.w) + a1[2] * bflo(g.w), bfhi(t.w) + a1[3] * bfhi(g.w));
                    *(u32x4*)(Y + (size_t)row * DM + col) = w; } }
    }
};
struct EpiGateChain {
    static constexpr bool PERM = true, AFTER_DRAIN = false, CHAIN = true;
    const bf16* Gt; bf16* Y;
    __device__ __forceinline__ void mid(f32x4 (&acc)[2][2][4][2], const Unit& u, int wr, int wc, int fr, int fq) const {
        const int row0 = u.pm * 256 + wr * 64 + fr, col0 = u.pn * 256 + wc * 32 + 8 * fq;
#pragma unroll
        for (int ai = 0; ai < 2; ++ai)
#pragma unroll
            for (int m = 0; m < 4; ++m) { const int row = row0 + ai * 128 + m * 16;
#pragma unroll
                for (int bj = 0; bj < 2; ++bj) { const bf16* gp = Gt + (size_t)row * GC + col0 + bj * 128; const u32x4 ga = *(const u32x4*)gp, gb = *(const u32x4*)(gp + 1024);
                    f32x4 r0, r1;
                    r0[0] = bflo(ga.x) * __builtin_amdgcn_rcpf(fmaxf(bflo(gb.x), 1e-30f)); r0[1] = bfhi(ga.x) * __builtin_amdgcn_rcpf(fmaxf(bfhi(gb.x), 1e-30f));
                    r0[2] = bflo(ga.y) * __builtin_amdgcn_rcpf(fmaxf(bflo(gb.y), 1e-30f)); r0[3] = bfhi(ga.y) * __builtin_amdgcn_rcpf(fmaxf(bfhi(gb.y), 1e-30f));
                    r1[0] = bflo(ga.z) * __builtin_amdgcn_rcpf(fmaxf(bflo(gb.z), 1e-30f)); r1[1] = bfhi(ga.z) * __builtin_amdgcn_rcpf(fmaxf(bfhi(gb.z), 1e-30f));
                    r1[2] = bflo(ga.w) * __builtin_amdgcn_rcpf(fmaxf(bflo(gb.w), 1e-30f)); r1[3] = bfhi(ga.w) * __builtin_amdgcn_rcpf(fmaxf(bfhi(gb.w), 1e-30f));
                    acc[ai][bj][m][0] = acc[ai][bj][m][0] * r0; acc[ai][bj][m][1] = acc[ai][bj][m][1] * r1; } }
    }
    __device__ __forceinline__ void operator()(const f32x4 (&acc)[2][2][4][2], const Unit& u, int wr, int wc, int fr, int fq) const {
        const int row0 = u.pm * 256 + wr * 64 + fr, col0 = u.pn * 256 + wc * 32 + 8 * fq;
#pragma unroll
        for (int ai = 0; ai < 2; ++ai) {
        u32x4 gv[4][2];
#pragma unroll
            for (int m = 0; m < 4; ++m)
#pragma unroll
                for (int bj = 0; bj < 2; ++bj) gv[m][bj] = *(const u32x4*)(Gt + (size_t)(row0 + ai * 128 + m * 16) * GC + 1024 + col0 + bj * 128);
        asm volatile("" ::: "memory");
#pragma unroll
            for (int m = 0; m < 4; ++m) { const int row = row0 + ai * 128 + m * 16;
#pragma unroll
                for (int bj = 0; bj < 2; ++bj) { const int col = col0 + bj * 128; const u32x4 g = gv[m][bj];
                    const f32x4 a0 = acc[ai][bj][m][0], a1 = acc[ai][bj][m][1]; u32x4 w;
                    w.x = pkbf(a0[0] * bflo(g.x), a0[1] * bfhi(g.x)); w.y = pkbf(a0[2] * bflo(g.y), a0[3] * bfhi(g.y));
                    w.z = pkbf(a1[0] * bflo(g.z), a1[1] * bfhi(g.z)); w.w = pkbf(a1[2] * bflo(g.w), a1[3] * bfhi(g.w));
                    *(u32x4*)(Y + (size_t)row * DM + col) = w; } }
        asm volatile("" ::: "memory"); }
    }
};
struct EpiRes {
    static constexpr bool PERM = true, AFTER_DRAIN = false, CHAIN = false;
    bf16* xb; float* ssq;
    __device__ __forceinline__ void operator()(const f32x4 (&acc)[2][2][4][2], const Unit& u, int wr, int wc, int fr, int fq) const {
        const int row0 = u.pm * 256 + wr * 64 + fr, col0 = u.pn * 256 + wc * 32 + 8 * fq;
#pragma unroll
        for (int ai = 0; ai < 2; ++ai) {
        u32x4 xv[4][2];
#pragma unroll
            for (int m = 0; m < 4; ++m)
#pragma unroll
                for (int bj = 0; bj < 2; ++bj) xv[m][bj] = *(const u32x4*)(xb + (size_t)(row0 + ai * 128 + m * 16) * DM + col0 + bj * 128);
        asm volatile("" ::: "memory");
#pragma unroll
            for (int m = 0; m < 4; ++m) { const int row = row0 + ai * 128 + m * 16; float s = 0.f;
#pragma unroll
                for (int bj = 0; bj < 2; ++bj) { bf16* p = xb + (size_t)row * DM + col0 + bj * 128; const u32x4 x = xv[m][bj];
                    const f32x4 a0 = acc[ai][bj][m][0], a1 = acc[ai][bj][m][1];
                    const float o0 = bflo(x.x) + a0[0], o1 = bfhi(x.x) + a0[1], o2 = bflo(x.y) + a0[2], o3 = bfhi(x.y) + a0[3];
                    const float o4 = bflo(x.z) + a1[0], o5 = bfhi(x.z) + a1[1], o6 = bflo(x.w) + a1[2], o7 = bfhi(x.w) + a1[3];
                    u32x4 w; w.x = pkbf(o0, o1); w.y = pkbf(o2, o3); w.z = pkbf(o4, o5); w.w = pkbf(o6, o7); *(u32x4*)p = w;
                    s += ((o0 * o0 + o1 * o1) + (o2 * o2 + o3 * o3)) + ((o4 * o4 + o5 * o5) + (o6 * o6 + o7 * o7)); }
                s += __shfl_xor(s, 16); s += __shfl_xor(s, 32);
                if (fq == 0) ssq[(size_t)row * 16 + u.pn * 4 + wc] = s; }
        asm volatile("" ::: "memory"); }
    }
};
struct EpiUp {
    static constexpr bool PERM = true, AFTER_DRAIN = false, CHAIN = false;
    bf16* U; const float* ssq;
    __device__ __forceinline__ void operator()(const f32x4 (&acc)[2][2][4][2], const Unit& u, int wr, int wc, int fr, int fq) const {
        const int row0 = u.pm * 256 + wr * 64 + fr, col0 = u.pn * 256 + wc * 32 + 8 * fq;
        float rsv[2][4]; f32x4 pvv[2][4];
#pragma unroll
        for (int ai = 0; ai < 2; ++ai)
#pragma unroll
            for (int m = 0; m < 4; ++m) pvv[ai][m] = *(const f32x4*)(ssq + (size_t)(row0 + ai * 128 + m * 16) * 16 + 4 * fq);
#pragma unroll
        for (int ai = 0; ai < 2; ++ai)
#pragma unroll
            for (int m = 0; m < 4; ++m) rsv[ai][m] = rs4_finish(pvv[ai][m]);
        asm volatile("" ::: "memory");
#pragma unroll
        for (int ai = 0; ai < 2; ++ai)
#pragma unroll
            for (int m = 0; m < 4; ++m) { const int row = row0 + ai * 128 + m * 16; const float rsc = rsv[ai][m];
#pragma unroll
                for (int bj = 0; bj < 2; ++bj) { float v[8];
#pragma unroll
                    for (int e = 0; e < 4; ++e) { v[e] = fmaxf(acc[ai][bj][m][0][e] * rsc, 0.f); v[4 + e] = fmaxf(acc[ai][bj][m][1][e] * rsc, 0.f); }
#pragma unroll
                    for (int e = 0; e < 8; ++e) v[e] *= v[e];
                    u32x4 w; w.x = pkbf(v[0], v[1]); w.y = pkbf(v[2], v[3]); w.z = pkbf(v[4], v[5]); w.w = pkbf(v[6], v[7]);
                    *(u32x4*)(U + (size_t)row * FF + col0 + bj * 128) = w; } }
    }
};

#define XB_TMO      128
#define XB_XCNT(j)  (256  + 64 * (j))
#define XB_XSUB(j)  (1280 + 64 * (j))
#define XB_XGEN(j)  (2304 + 64 * (j))
#define XB_TOP      3328
#define XB_TOPGEN   3392
#define XCD_BAR_WORDS 3456
#define XB_SPIN_CAP (1u << 18)

__device__ __forceinline__ unsigned xb_ld(unsigned* p)              { return __hip_atomic_load(p, __ATOMIC_RELAXED, __HIP_MEMORY_SCOPE_AGENT); }
__device__ __forceinline__ unsigned xb_add(unsigned* p, unsigned v) { return __hip_atomic_fetch_add(p, v, __ATOMIC_RELAXED, __HIP_MEMORY_SCOPE_AGENT); }
__device__ __forceinline__ unsigned xb_xcc_id() { return (unsigned)__builtin_amdgcn_s_getreg((3 << 11) | 20) & 0xFu; }
#define XB_SPIN(cond, bar) do { unsigned _sp = 0; while (cond) { __builtin_amdgcn_s_sleep(1); \
    if ((++_sp & 255u) == 0u) { if (xb_ld(&(bar)[XB_TMO])) break; if (_sp > XB_SPIN_CAP) { atomicAdd(&(bar)[XB_TMO], 1u); break; } } } } while (0)

struct XcdBarrier {
    unsigned* bar; unsigned x;
    volatile LAS unsigned* st;
};

__device__ __forceinline__ XcdBarrier xcd_barrier_post(unsigned* bar, volatile LAS unsigned* st) {
    XcdBarrier b; b.bar = bar; b.x = xb_xcc_id(); b.st = st;
    if (threadIdx.x == 0) (void)xb_add(&bar[XB_XCNT(b.x)], 1u);
    return b;
}
__device__ __forceinline__ void xcd_barrier_complete(unsigned* bar, unsigned x, unsigned& nloc, unsigned& nx) {
    const unsigned G = gridDim.x * gridDim.y * gridDim.z;
    unsigned sum, cnt, mine, sp = 0u;
    for (;;) {
        sum = 0u; cnt = 0u; mine = 0u;
#pragma unroll
        for (unsigned j = 0; j < 16; ++j) { const unsigned c = xb_ld(&bar[XB_XCNT(j)]); sum += c; cnt += (c > 0u) ? 1u : 0u; mine = (j == x) ? c : mine; }
        if (sum == G) break;
        __builtin_amdgcn_s_sleep(1);
        if ((++sp & 255u) == 0u) { if (xb_ld(&bar[XB_TMO])) break; if (sp > XB_SPIN_CAP) { atomicAdd(&bar[XB_TMO], 1u); break; } }
    }
    nloc = mine > 0u ? mine : 1u; nx = cnt > 0u ? cnt : 1u;
}

__device__ __forceinline__ void xcd_barrier(const XcdBarrier& b) {
    asm volatile("s_waitcnt vmcnt(0)" ::: "memory");
    __syncthreads();
    if (threadIdx.x == 0) {
        unsigned* bar = b.bar;
        __builtin_amdgcn_s_waitcnt(0);
        unsigned nloc = b.st[0], nx = b.st[1];
        if (nloc == 0u) { xcd_barrier_complete(bar, b.x, nloc, nx); b.st[0] = nloc; b.st[1] = nx; }
        const unsigned old = xb_add(&bar[XB_XSUB(b.x)], 1u);
        const unsigned gen = old / nloc;
        if (old + 1u == (gen + 1u) * nloc) {
            __builtin_amdgcn_fence(__ATOMIC_RELEASE, "agent");
            asm volatile("s_waitcnt vmcnt(0)" ::: "memory");
            const unsigned og = xb_add(&bar[XB_TOP], 1u);
            const unsigned tg = og / nx;
            if (og + 1u == (tg + 1u) * nx) xb_add(&bar[XB_TOPGEN], 1u);
            else XB_SPIN(xb_ld(&bar[XB_TOPGEN]) == tg, bar);
            __builtin_amdgcn_fence(__ATOMIC_ACQUIRE, "agent");
            xb_add(&bar[XB_XGEN(b.x)], 1u);
            asm volatile("s_waitcnt vmcnt(0)" ::: "memory");
        } else {
            XB_SPIN(xb_ld(&bar[XB_XGEN(b.x)]) == gen, bar);
            __builtin_amdgcn_fence(__ATOMIC_ACQUIRE, "agent");
            asm volatile("s_waitcnt vmcnt(0)" ::: "memory");
        }
    }
    __syncthreads();
}

__device__ __forceinline__ void tr_item(const float* W, int ldw, int K, int k0, int nsrc0, bf16* WT, int ndst0, const float* gain, LAS float* scr, int lane) {
    float v[32];
    const float* wp = W + (size_t)(k0 + (lane >> 5)) * ldw + nsrc0 + (lane & 31);
#pragma unroll
    for (int i = 0; i < 32; ++i) v[i] = wp[(size_t)(2 * i) * ldw];
    if (gain) {
        const float* gp = gain + k0 + (lane >> 5);
#pragma unroll
        for (int i = 0; i < 32; ++i) v[i] *= gp[2 * i];
    }
#pragma unroll
    for (int i = 0; i < 32; ++i) scr[(2 * i + (lane >> 5)) * 33 + (lane & 31)] = v[i];
    asm volatile("s_waitcnt lgkmcnt(0)" ::: "memory");
    const int c = lane & 7;
#pragma unroll
    for (int j = 0; j < 4; ++j) { const int n = (lane >> 3) + 8 * j; const LAS float* s = scr + (8 * c) * 33 + n;
        u32x4 o; o.x = pkbf(s[0 * 33], s[1 * 33]); o.y = pkbf(s[2 * 33], s[3 * 33]); o.z = pkbf(s[4 * 33], s[5 * 33]); o.w = pkbf(s[6 * 33], s[7 * 33]);
        *(u32x4*)(WT + (size_t)(ndst0 + n) * K + k0 + 8 * c) = o; }
    asm volatile("s_waitcnt lgkmcnt(0)" ::: "memory");
}
__device__ __forceinline__ void xb_row(const float* xrow, bf16* orow, float* ssq, int lane) {
    const f32x4* xr = (const f32x4*)xrow + lane; f32x4 v[4]; float s = 0.f;
#pragma unroll
    for (int j = 0; j < 4; ++j) { v[j] = xr[64 * j]; s += (v[j][0] * v[j][0] + v[j][1] * v[j][1]) + (v[j][2] * v[j][2] + v[j][3] * v[j][3]); }
    s = wave_sum(s);
    u32x2* o = (u32x2*)orow + lane;
#pragma unroll
    for (int j = 0; j < 4; ++j) { u32x2 w; w.x = pkbf(v[j][0], v[j][1]); w.y = pkbf(v[j][2], v[j][3]); o[64 * j] = w; }
    if (lane < 16) ssq[lane] = lane == 0 ? s : 0.f;
}
__device__ __forceinline__ void final_row(const bf16* xrow, float* orow, const float* g, int lane) {
    const u32x2* xr = (const u32x2*)xrow + lane; const f32x4* gr = (const f32x4*)g + lane; f32x4 v[4]; float s = 0.f;
#pragma unroll
    for (int j = 0; j < 4; ++j) { const u32x2 w = xr[64 * j]; v[j] = (f32x4){bflo(w.x), bfhi(w.x), bflo(w.y), bfhi(w.y)}; s += (v[j][0] * v[j][0] + v[j][1] * v[j][1]) + (v[j][2] * v[j][2] + v[j][3] * v[j][3]); }
    s = wave_sum(s); const float r = rsqrtf(s * (1.0f / 1024.0f) + EPS);
    f32x4* o = (f32x4*)orow + lane;
#pragma unroll
    for (int j = 0; j < 4; ++j) o[64 * j] = v[j] * r * gr[64 * j];
}

#define LBAR() do { asm volatile("s_waitcnt lgkmcnt(0)" ::: "memory"); __builtin_amdgcn_s_barrier(); asm volatile("" ::: "memory"); } while (0)
__device__ __forceinline__ void hgrn_a_loads(const bf16* zbuf, int ch, int tid, unsigned (&lw)[8]) {
    const int bl = ch >> 8, h = (ch >> 6) & 3, c = ch & 63, m0 = bl * 4096 + c * 64, kp = tid & 63, seg = tid >> 6;
    const bf16* lfp = zbuf + (size_t)(m0 + 8 * seg) * ZC + 512 + h * 128 + 2 * kp;
#pragma unroll
    for (int i = 0; i < 8; ++i) lw[i] = *(const unsigned*)(lfp + (size_t)i * ZC);
}
__device__ __forceinline__ void hgrn_passA(LAS unsigned char* lds, const bf16* zbuf, const bf16* VT, bf16* KVT, float* dec, int ch, int nxt, unsigned (&lw)[8]) {
    int tid = threadIdx.x; asm volatile("" : "+v"(tid)); const int wid = __builtin_amdgcn_readfirstlane(tid >> 6), lane = tid & 63;
    const int bl = ch >> 8, h = (ch >> 6) & 3, c = ch & 63, m0 = bl * 4096 + c * 64;
    LAS float* segsum = (LAS float*)lds; LAS unsigned char* kdT = lds + 4096;
    const int kp = tid & 63, k0 = 2 * kp, seg = tid >> 6;
    const int i16 = lane & 15, kq = lane >> 4, v0 = 16 * wid;
    const bf16* vp = VT + (size_t)(h * 128 + v0 + i16) * MP + m0 + 8 * kq;
    const bf16x8 a0 = *(const bf16x8*)vp, a1 = *(const bf16x8*)(vp + 32);
    float lfa[8], lfb[8]; float ra = 0.f, rb = 0.f;
#pragma unroll
    for (int i = 0; i < 8; ++i) { const f16x2_t hv = __builtin_bit_cast(f16x2_t, lw[i]); lfa[i] = (float)hv[0]; lfb[i] = (float)hv[1]; ra += lfa[i]; rb += lfb[i]; }
    *(LAS f32x2_t*)(segsum + seg * 128 + k0) = (f32x2_t){ra, rb};
    if (nxt < 1024) hgrn_a_loads(zbuf, nxt, tid, lw);
    LBAR();
    float offa = 0.f, offb = 0.f, bla = 0.f, blb = 0.f;
#pragma unroll
    for (int s = 0; s < 8; ++s) { const f32x2_t sv = *(const LAS f32x2_t*)(segsum + s * 128 + k0); if (s < seg) { offa += sv[0]; offb += sv[1]; } bla += sv[0]; blb += sv[1]; }
    float kda[8], kdb[8]; float ba = offa, bb = offb;
#pragma unroll
    for (int i = 0; i < 8; ++i) { ba += lfa[i]; bb += lfb[i]; kda[i] = (1.f - __expf(lfa[i])) * __expf(bla - ba); kdb[i] = (1.f - __expf(lfb[i])) * __expf(blb - bb); }
    u32x4 w0, w1; w0.x = pkbf(kda[0], kda[1]); w0.y = pkbf(kda[2], kda[3]); w0.z = pkbf(kda[4], kda[5]); w0.w = pkbf(kda[6], kda[7]);
    w1.x = pkbf(kdb[0], kdb[1]); w1.y = pkbf(kdb[2], kdb[3]); w1.z = pkbf(kdb[4], kdb[5]); w1.w = pkbf(kdb[6], kdb[7]);
    *(LAS u32x4*)(kdT + k0 * 144 + seg * 16) = w0; *(LAS u32x4*)(kdT + (k0 + 1) * 144 + seg * 16) = w1;
    if (seg == 0) *(f32x2_t*)(dec + ch * 128 + k0) = (f32x2_t){__expf(bla), __expf(blb)};
    LBAR();
    bf16* outp = KVT + (size_t)ch * 16384 + wid * 2048 + i16 * 8 + (kq >> 1) * 128 + (kq & 1) * 4;
#pragma unroll
    for (int kt = 0; kt < 8; ++kt) {
        f32x4 acc = {0.f, 0.f, 0.f, 0.f};
        const LAS unsigned char* bp = kdT + (16 * kt + i16) * 144 + 16 * kq;
        acc = MFMA16(*(const LAS bf16x8*)bp, a0, acc); acc = MFMA16(*(const LAS bf16x8*)(bp + 64), a1, acc);
        u32x2 w; w.x = pkbf(acc[0], acc[1]); w.y = pkbf(acc[2], acc[3]); *(u32x2*)(outp + 256 * kt) = w;
    }
    LBAR();
}
__device__ __forceinline__ void hgrn_scan(const bf16* KVT, const float* dec, bf16* ST, int gid, int gstride) {
    asm volatile("" : "+v"(gid));
    for (int id = gid; id < 16 * 8192; id += gstride) {
        const int bh = id >> 13, e2 = id & 8191, idx = 2 * e2, k = ((idx >> 9) & 3) * 32 + ((idx & 511) >> 7) * 8 + (idx & 7);
        float sa = 0.f, sb = 0.f;
#pragma unroll 8
        for (int c = 0; c < 64; ++c) { const int ch = bh * 64 + c;
            *(unsigned*)(ST + (size_t)ch * 16384 + idx) = pkbf(sa, sb);
            const f32x2_t d = *(const f32x2_t*)(dec + ch * 128 + k); const unsigned kv = *(const unsigned*)(KVT + (size_t)ch * 16384 + idx);
            sa = d[0] * sa + bflo(kv); sb = d[1] * sb + bfhi(kv); }
    }
}
__device__ __forceinline__ void hgrn_c_loads(const bf16* zbuf, int ch, int tid, unsigned (&lw)[8], unsigned (&qw)[8]) {
    const int bl = ch >> 8, h = (ch >> 6) & 3, c = ch & 63, m0 = bl * 4096 + c * 64, kp = tid & 63, seg = tid >> 6;
    const bf16* zp = zbuf + (size_t)(m0 + 8 * seg) * ZC + h * 128 + 2 * kp;
#pragma unroll
    for (int i = 0; i < 8; ++i) { lw[i] = *(const unsigned*)(zp + (size_t)i * ZC + 512); qw[i] = *(const unsigned*)(zp + (size_t)i * ZC); }
}
__device__ __forceinline__ void hgrn_passC(LAS unsigned char* lds, const bf16* zbuf, const bf16* VT, const bf16* ST, const float* hgg, bf16* ohg, int ch, int nxt, unsigned (&lw)[8], unsigned (&qw)[8]) {
    int tid = threadIdx.x; asm volatile("" : "+v"(tid)); const int wid = __builtin_amdgcn_readfirstlane(tid >> 6), lane = tid & 63;
    const int bl = ch >> 8, h = (ch >> 6) & 3, c = ch & 63, m0 = bl * 4096 + c * 64;
    constexpr int PITCH = 272;
    LAS float* segsum = (LAS float*)lds; LAS float* ssqL = (LAS float*)(lds + 4096);
    LAS unsigned char* qbL = lds + 8192; LAS unsigned char* kbL = qbL + 64 * PITCH; LAS unsigned char* qsL = kbL + 64 * PITCH;
    const int kp = tid & 63, k0 = 2 * kp, seg = tid >> 6;
    const int j = lane & 15, kq = lane >> 4, tt = wid & 3, vh = wid >> 2, t0 = 16 * tt;
    LAS unsigned char* stF = lds + 65536;
    LAS unsigned char* vtF = lds + 98304;
    {   const bf16* sp = ST + (size_t)ch * 16384 + wid * 2048 + lane * 8;
#pragma unroll
        for (int q = 0; q < 4; ++q) __builtin_amdgcn_global_load_lds((const unsigned*)(sp + 512 * q), (LAS unsigned*)(stF + (4 * wid + q) * 1024), 16, 0, 0);
        const bf16* vp = VT + (size_t)(h * 128 + 16 * wid + j) * MP + m0 + 8 * kq;
#pragma unroll
        for (int q = 0; q < 2; ++q) __builtin_amdgcn_global_load_lds((const unsigned*)(vp + 32 * q), (LAS unsigned*)(vtF + (2 * wid + q) * 1024), 16, 0, 0); }
    const size_t row = (size_t)(m0 + t0 + j);
    f32x4 gg[4]; u32x2 zg[4];
#pragma unroll
    for (int vt = 0; vt < 4; ++vt) { const int v = 64 * vh + 16 * vt + 4 * kq; gg[vt] = *(const f32x4*)(hgg + h * 128 + v); zg[vt] = *(const u32x2*)(zbuf + row * ZC + 1024 + h * 128 + v); }
    float lfa[8], lfb[8]; float ra = 0.f, rb = 0.f;
#pragma unroll
    for (int i = 0; i < 8; ++i) { const f16x2_t hv = __builtin_bit_cast(f16x2_t, lw[i]); lfa[i] = (float)hv[0]; lfb[i] = (float)hv[1]; ra += lfa[i]; rb += lfb[i]; }
    *(LAS f32x2_t*)(segsum + seg * 128 + k0) = (f32x2_t){ra, rb};
    LBAR();
    float offa = 0.f, offb = 0.f, bma = 0.f, bmb = 0.f;
#pragma unroll
    for (int s = 0; s < 8; ++s) { const f32x2_t sv = *(const LAS f32x2_t*)(segsum + s * 128 + k0); if (s < seg) { offa += sv[0]; offb += sv[1]; } if (s < 4) { bma += sv[0]; bmb += sv[1]; } }
    float ba = offa, bb = offb;
#pragma unroll
    for (int i = 0; i < 8; ++i) { ba += lfa[i]; bb += lfb[i]; const int t = 8 * seg + i; const float qa = bflo(qw[i]), qb_ = bfhi(qw[i]);
        const float da = fminf(fmaxf(ba - bma, -80.f), 80.f), db = fminf(fmaxf(bb - bmb, -80.f), 80.f);
        *(LAS unsigned*)(qbL + t * PITCH + 4 * kp) = pkbf(qa * __expf(da), qb_ * __expf(db));
        *(LAS unsigned*)(kbL + t * PITCH + 4 * kp) = pkbf((1.f - __expf(lfa[i])) * __expf(-da), (1.f - __expf(lfb[i])) * __expf(-db));
        *(LAS unsigned*)(qsL + t * PITCH + 4 * kp) = pkbf(qa * __expf(ba), qb_ * __expf(bb)); }
    asm volatile("s_waitcnt vmcnt(0)" ::: "memory");
    LBAR();
    if (nxt < 1024) hgrn_c_loads(zbuf, nxt, tid, lw, qw);
    f32x4 acc[4];
#pragma unroll
    for (int vt = 0; vt < 4; ++vt) acc[vt] = (f32x4){0.f, 0.f, 0.f, 0.f};
    {
#pragma unroll
        for (int ks = 0; ks < 4; ++ks) { const bf16x8 bq = *(const LAS bf16x8*)(qsL + (t0 + j) * PITCH + (32 * ks + 8 * kq) * 2);
#pragma unroll
            for (int vt = 0; vt < 4; ++vt) acc[vt] = MFMA16(*(const LAS bf16x8*)(stF + ((4 * vh + vt) * 4 + ks) * 1024 + lane * 16), bq, acc[vt]); } }
#pragma unroll
    for (int sb = 0; sb < 2; ++sb) { if (sb > (tt >> 1)) break;
        const int sbase = 32 * sb, sr0 = sbase + 8 * (j >> 2) + (j & 3);
        f32x4 p0 = {0.f, 0.f, 0.f, 0.f}, p1 = {0.f, 0.f, 0.f, 0.f};
#pragma unroll
        for (int ks = 0; ks < 4; ++ks) { const bf16x8 bq = *(const LAS bf16x8*)(qbL + (t0 + j) * PITCH + (32 * ks + 8 * kq) * 2);
            p0 = MFMA16(*(const LAS bf16x8*)(kbL + sr0 * PITCH + (32 * ks + 8 * kq) * 2), bq, p0);
            p1 = MFMA16(*(const LAS bf16x8*)(kbL + (sr0 + 4) * PITCH + (32 * ks + 8 * kq) * 2), bq, p1); }
        const int t = t0 + j, sk = sbase + 8 * kq;
#pragma unroll
        for (int e = 0; e < 4; ++e) { if (sk + e > t) p0[e] = 0.f; if (sk + 4 + e > t) p1[e] = 0.f; }
        u32x4 pw; pw.x = pkbf(p0[0], p0[1]); pw.y = pkbf(p0[2], p0[3]); pw.z = pkbf(p1[0], p1[1]); pw.w = pkbf(p1[2], p1[3]);
        const bf16x8 pb = __builtin_bit_cast(bf16x8, pw);
#pragma unroll
        for (int vt = 0; vt < 4; ++vt) acc[vt] = MFMA16(*(const LAS bf16x8*)(vtF + ((4 * vh + vt) * 2 + sb) * 1024 + lane * 16), pb, acc[vt]);
    }
    float ss = 0.f;
#pragma unroll
    for (int vt = 0; vt < 4; ++vt) ss += (acc[vt][0] * acc[vt][0] + acc[vt][1] * acc[vt][1]) + (acc[vt][2] * acc[vt][2] + acc[vt][3] * acc[vt][3]);
    ss += __shfl_xor(ss, 16); ss += __shfl_xor(ss, 32);
    if (kq == 0) ssqL[(vh * 4 + tt) * 16 + j] = ss;
    LBAR();
    const float tot = ssqL[tt * 16 + j] + ssqL[(4 + tt) * 16 + j];
    const float rinv = rsqrtf(tot * (1.0f / 128.0f) + EPS);
#pragma unroll
    for (int vt = 0; vt < 4; ++vt) { const int v = 64 * vh + 16 * vt + 4 * kq;
        u32x2 w; w.x = pkbf(acc[vt][0] * rinv * gg[vt][0] * bflo(zg[vt].x), acc[vt][1] * rinv * gg[vt][1] * bfhi(zg[vt].x)); w.y = pkbf(acc[vt][2] * rinv * gg[vt][2] * bflo(zg[vt].y), acc[vt][3] * rinv * gg[vt][3] * bfhi(zg[vt].y));
        *(u32x2*)(ohg + row * 512 + h * 128 + v) = w; }
    LBAR();
}

__device__ __forceinline__ float xrow16_max(float x) {
    auto s = __builtin_amdgcn_permlane16_swap(__float_as_uint(x), __float_as_uint(x), false, false); x = fmaxf(__uint_as_float(s[0]), __uint_as_float(s[1]));
    auto t = __builtin_amdgcn_permlane32_swap(__float_as_uint(x), __float_as_uint(x), false, false); return fmaxf(__uint_as_float(t[0]), __uint_as_float(t[1])); }
__device__ __forceinline__ float xrow16_sum(float x) {
    auto s = __builtin_amdgcn_permlane16_swap(__float_as_uint(x), __float_as_uint(x), false, false); x = __uint_as_float(s[0]) + __uint_as_float(s[1]);
    auto t = __builtin_amdgcn_permlane32_swap(__float_as_uint(x), __float_as_uint(x), false, false); return __uint_as_float(t[0]) + __uint_as_float(t[1]); }
__device__ __forceinline__ void attn_unit(LAS unsigned char* lds, const bf16* zbuf, const bf16* VT, bf16* og, float* lse, int bh, int g, int r, int qt, bool second) {
    int tid = threadIdx.x; asm volatile("" : "+v"(tid));
    const int lane = tid & 63, wid = __builtin_amdgcn_readfirstlane(tid >> 6), j = lane & 15, rq = lane >> 4;
    const int bl = bh >> 2, h = bh & 3;
    const int ld = 2 * g, per = 4096 >> ld, M0 = 128 * qt, gblk0 = 4 * qt - 4;
    {
        const int kbs = second ? 4 + (wid >> 1) : wid; const bool doK = !second || !(wid & 1), doV = !second || (wid & 1);
        const int mkb = M0 - 128 + 32 * kbs;
        LAS unsigned char* slot = lds + ((gblk0 + kbs) & 7) * 16384;
        if (mkb + 31 >= 0) {
            const bf16* kbase = zbuf + (size_t)(bl * 4096) * ZC + 3072 + g * 512 + h * 128 + 8 * rq;
            const bf16* vbase = VT + (size_t)(512 + g * 512 + h * 128 + j) * MP + bl * 4096 + r * per;
            const int mk0 = mkb + 8 * (j >> 2) + (j & 3), mk1 = mk0 + 4;
            const int mk0c = min(max(mk0, 0), per - 1), mk1c = min(max(mk1, 0), per - 1);
            const bf16* k0p = kbase + (size_t)((mk0c << ld) + r) * ZC; const bf16* k1p = kbase + (size_t)((mk1c << ld) + r) * ZC;
            const bf16* vp = vbase + min(max(mkb + 8 * rq, 0), per - 8);
            if (doK) {
#pragma unroll
                for (int ks = 0; ks < 4; ++ks) {
                    __builtin_amdgcn_global_load_lds((const unsigned*)(k0p + 32 * ks), (LAS unsigned*)(slot + ks * 1024), 16, 0, 0);
                    __builtin_amdgcn_global_load_lds((const unsigned*)(k1p + 32 * ks), (LAS unsigned*)(slot + 4096 + ks * 1024), 16, 0, 0); } }
            if (doV) {
#pragma unroll
                for (int dt = 0; dt < 8; ++dt) __builtin_amdgcn_global_load_lds((const unsigned*)(vp + (size_t)dt * 16 * MP), (LAS unsigned*)(slot + 8192 + dt * 1024), 16, 0, 0); }
        }
    }
    const int mqj = M0 + 16 * wid + j;
    const size_t qrow = (size_t)(bl * 4096 + (mqj << ld) + r);
    const bf16* qp = zbuf + qrow * ZC + 1536 + g * 512 + h * 128 + 8 * rq;
    bf16x8 qf[4];
#pragma unroll
    for (int ks = 0; ks < 4; ++ks) qf[ks] = *(const bf16x8*)(qp + 32 * ks);
    f32x4 acc[8];
#pragma unroll
    for (int dt = 0; dt < 8; ++dt) acc[dt] = (f32x4){0.f, 0.f, 0.f, 0.f};
    float mrun = -1e30f, lrun = 0.f;
    const int klo = max(mqj - 128, 0); const unsigned kspan = (unsigned)(mqj - klo); const int mq0w = M0 + 16 * wid;
    asm volatile("s_waitcnt vmcnt(0)" ::: "memory");
    __syncthreads();
    const int kb0 = (16 * wid) >> 5, kb1 = (16 * wid + 143) >> 5;
    for (int kb = kb0; kb <= kb1; ++kb) {
        const int mkb = M0 - 128 + 32 * kb;
        if (mkb + 31 < 0) continue;
        const LAS unsigned char* mine = lds + ((gblk0 + kb) & 7) * 16384 + lane * 16;
        bf16x8 k0[4], k1[4], vf[8];
#pragma unroll
        for (int ks = 0; ks < 4; ++ks) { k0[ks] = *(const LAS bf16x8*)(mine + ks * 1024); k1[ks] = *(const LAS bf16x8*)(mine + 4096 + ks * 1024); }
#pragma unroll
        for (int dt = 0; dt < 8; ++dt) vf[dt] = *(const LAS bf16x8*)(mine + 8192 + dt * 1024);
        f32x4 s0 = {0.f, 0.f, 0.f, 0.f}, s1 = {0.f, 0.f, 0.f, 0.f};
        __builtin_amdgcn_s_setprio(1);
#pragma unroll
        for (int ks = 0; ks < 4; ++ks) { s0 = MFMA16(k0[ks], qf[ks], s0); s1 = MFMA16(k1[ks], qf[ks], s1); }
        __builtin_amdgcn_s_setprio(0);
        const int kb_ = mkb + 8 * rq - klo; float bm = -1e30f;
        if (!(mkb >= mq0w - 113 && mkb + 31 <= mq0w && mkb >= 0)) {
#pragma unroll
            for (int e = 0; e < 4; ++e) {
                if ((unsigned)(kb_ + e) > kspan) s0[e] = -1e30f;
                if ((unsigned)(kb_ + 4 + e) > kspan) s1[e] = -1e30f; } }
#pragma unroll
        for (int e = 0; e < 4; ++e) bm = fmaxf(bm, fmaxf(s0[e], s1[e]));
        bm = xrow16_max(bm);
        if (__builtin_amdgcn_ballot_w64(bm > mrun + 8.0f) != 0ull) {
            const float mn = fmaxf(mrun, bm), alpha = __builtin_amdgcn_exp2f(mrun - mn); mrun = mn; lrun *= alpha;
#pragma unroll
            for (int dt = 0; dt < 8; ++dt) acc[dt] = acc[dt] * alpha;
        }
        float ps = 0.f;
#pragma unroll
        for (int e = 0; e < 4; ++e) { s0[e] = __builtin_amdgcn_exp2f(s0[e] - mrun); s1[e] = __builtin_amdgcn_exp2f(s1[e] - mrun); ps += s0[e] + s1[e]; }
        lrun += ps;
        u32x4 pw; pw.x = pkbf(s0[0], s0[1]); pw.y = pkbf(s0[2], s0[3]); pw.z = pkbf(s1[0], s1[1]); pw.w = pkbf(s1[2], s1[3]);
        const bf16x8 pb = __builtin_bit_cast(bf16x8, pw);
        __builtin_amdgcn_s_setprio(1);
#pragma unroll
        for (int dt = 0; dt < 8; ++dt) acc[dt] = MFMA16(vf[dt], pb, acc[dt]);
        __builtin_amdgcn_s_setprio(0);
    }
    lrun = xrow16_sum(lrun);
    const float inv = 1.0f / lrun;
    bf16* op = og + qrow * 512 + h * 128 + 4 * rq;
#pragma unroll
    for (int dt = 0; dt < 8; ++dt) { u32x2 w; w.x = pkbf(acc[dt][0] * inv, acc[dt][1] * inv); w.y = pkbf(acc[dt][2] * inv, acc[dt][3] * inv); *(u32x2*)(op + 16 * dt) = w; }
    if (rq == 0) lse[qrow * 4 + h] = mrun + __builtin_amdgcn_logf(lrun);
    __syncthreads();
}
__device__ __forceinline__ void attn_merge(const bf16* og0, const bf16* og1, const bf16* og2, const float* lse0, const float* lse1, const float* lse2, bf16* oatt, int gid, int gstride) {
    asm volatile("" : "+v"(gid));
    for (int id = gid; id < MP * 64; id += gstride) {
        const int row = id >> 6, hc = id & 63, h = hc >> 4;
        const float l0 = lse0[row * 4 + h], l1 = lse1[row * 4 + h], l2 = lse2[row * 4 + h];
        const float mx = fmaxf(l0, fmaxf(l1, l2));
        float w0 = __builtin_amdgcn_exp2f(l0 - mx), w1 = __builtin_amdgcn_exp2f(l1 - mx), w2 = __builtin_amdgcn_exp2f(l2 - mx);
        const float inv = 1.0f / (w0 + w1 + w2); w0 *= inv; w1 *= inv; w2 *= inv;
        const size_t off = (size_t)row * 512 + hc * 8;
        const u32x4 a = *(const u32x4*)(og0 + off), b = *(const u32x4*)(og1 + off), c = *(const u32x4*)(og2 + off);
        u32x4 o;
        o.x = pkbf(w0 * bflo(a.x) + w1 * bflo(b.x) + w2 * bflo(c.x), w0 * bfhi(a.x) + w1 * bfhi(b.x) + w2 * bfhi(c.x));
        o.y = pkbf(w0 * bflo(a.y) + w1 * bflo(b.y) + w2 * bflo(c.y), w0 * bfhi(a.y) + w1 * bfhi(b.y) + w2 * bfhi(c.y));
        o.z = pkbf(w0 * bflo(a.z) + w1 * bflo(b.z) + w2 * bflo(c.z), w0 * bfhi(a.z) + w1 * bfhi(b.z) + w2 * bfhi(c.z));
        o.w = pkbf(w0 * bflo(a.w) + w1 * bflo(b.w) + w2 * bflo(c.w), w0 * bfhi(a.w) + w1 * bfhi(b.w) + w2 * bfhi(c.w));
        *(u32x4*)(oatt + off) = o;
    }
}

struct Args { const float* in[12]; float* out; unsigned char* ws; };
__global__ void __launch_bounds__(512, 2) hyb_fwd(Args a) {
    extern __shared__ __attribute__((aligned(16))) unsigned char lds_raw[];
    LAS unsigned char* lds = (LAS unsigned char*)lds_raw;
    cg::grid_group grid = cg::this_grid();
    const int tid = threadIdx.x, lane = tid & 63, wid = __builtin_amdgcn_readfirstlane(tid >> 6);
    const int G = gridDim.x, bx = blockIdx.x, gw = bx * 8 + wid, NGW = G * 8;
    const float* x = a.in[0]; const float* norm1_g = a.in[1]; const float* w_in = a.in[2]; const float* hg_lb = a.in[3]; const float* hg_norm_g = a.in[4];
    const float* w_a = a.in[5]; const float* w_b = a.in[6]; const float* w_out = a.in[7]; const float* norm2_g = a.in[8]; const float* w_up = a.in[9]; const float* w_down = a.in[10]; const float* gfinal = a.in[11];
    unsigned char* ws = a.ws;
    float* ssq = (float*)(ws + WS_SSQ); float* lbv = (float*)(ws + WS_LB); float* rc = (float*)(ws + WS_COS); float* rs = (float*)(ws + WS_SIN);
    bf16* W = (bf16*)(ws + WS_W); bf16* xb = (bf16*)(ws + WS_XB); bf16* ST = (bf16*)((unsigned char*)a.out + 64 * MiB);     bf16* zbuf = (bf16*)(ws + WS_Z);
    bf16* tmp = (bf16*)(ws + WS_Z); bf16* ybuf = (bf16*)(ws + WS_Z + 64 * MiB); bf16* ubuf = (bf16*)(ws + WS_Z);
    bf16* gt = (bf16*)(ws + WS_GT); bf16* VT = (bf16*)(ws + WS_VT); bf16* ohg = (bf16*)(ws + WS_OHG); bf16* oatt = (bf16*)(ws + WS_OATT);
    bf16* KVT = (bf16*)(ws + WS_KVT); float* dec = (float*)(ws + WS_DEC);
    bf16* og2 = (bf16*)(ws + WS_OG2); float* lsev = (float*)(ws + WS_LSE);
    unsigned* barw = (unsigned*)(ws + WS_BAR);
    volatile LAS unsigned* bst = (volatile LAS unsigned*)(lds + LDS_BYTES - 64);
    if (tid < 2) bst[tid] = 0u;
    for (int i = bx * 512 + tid; i < XCD_BAR_WORDS; i += G * 512) barw[i] = 0u;

#define GSYNC() do { for (int s_ = 0; s_ < REP_SYNC; ++s_) xcd_barrier(xbar); } while (0)
    for (int rep0_ = 0; rep0_ < REP_PRO; ++rep0_)
    {
        LAS float* scr = (LAS float*)(lds + wid * 16384);
        for (int it = gw; it < 2 * 9472; it += NGW) {
            const int l = it >= 9472 ? 1 : 0; int r = it - l * 9472;
            const float* src; int ldw, K, k0, nsrc0, ndst0; bf16* dst; const float* gain = nullptr; bf16* wl = W + (size_t)l * L_ELEMS;
            if (r < 3328) { const int nb = r % 208, kb = r / 208, n0 = nb * 32; src = w_in + (size_t)l * 1024 * NIN; ldw = NIN; K = 1024; k0 = kb * 64; nsrc0 = n0 < 1024 ? n0 : (n0 < 4608 ? n0 + 512 : n0 + 2048); dst = wl + W_MAIN; ndst0 = n0; gain = norm1_g + l * 1024; }
            else if ((r -= 3328) < 1024) { const int nb = r % 64, kb = r / 64, n0 = nb * 32; src = w_in + (size_t)l * 1024 * NIN; ldw = NIN; K = 1024; k0 = kb * 64; nsrc0 = n0 < 512 ? 1024 + n0 : 4608 + n0; dst = wl + W_V; ndst0 = n0; gain = norm1_g + l * 1024; }
            else if ((r -= 1024) < 256) { const int nb = r % 32, kb = r / 32; src = w_a + (size_t)l * 512 * 1024; ldw = 1024; K = 512; k0 = kb * 64; nsrc0 = nb * 32; dst = wl + W_A; ndst0 = nb * 32; }
            else if ((r -= 256) < 256) { const int nb = r % 32, kb = r / 32; src = w_b + (size_t)l * 512 * 1024; ldw = 1024; K = 512; k0 = kb * 64; nsrc0 = nb * 32; dst = wl + W_B; ndst0 = nb * 32; }
            else if ((r -= 256) < 512) { const int nb = r % 32, kb = r / 32; src = w_out + (size_t)l * 1024 * 1024; ldw = 1024; K = 1024; k0 = kb * 64; nsrc0 = nb * 32; dst = wl + W_OUT; ndst0 = nb * 32; }
            else if ((r -= 512) < 2048) { const int nb = r % 128, kb = r / 128; src = w_up + (size_t)l * 1024 * 4096; ldw = 4096; K = 1024; k0 = kb * 64; nsrc0 = nb * 32; dst = wl + W_UP; ndst0 = nb * 32; gain = norm2_g + l * 1024; }
            else { r -= 2048; const int nb = r % 32, kb = r / 32; src = w_down + (size_t)l * 4096 * 1024; ldw = 1024; K = 4096; k0 = kb * 64; nsrc0 = nb * 32; dst = wl + W_DOWN; ndst0 = nb * 32; }
            tr_item(src, ldw, K, k0, nsrc0, dst, ndst0, gain, scr, lane);
        }
        const int gt_ = bx * 512 + tid, GT = G * 512;
        for (int idx = gt_; idx < 16; idx += GT) rc[idx] = powf(500000.0f, -(float)idx / 16.0f);
        for (int idx = gt_; idx < 1024; idx += GT) { const int k = idx & 511; lbv[idx] = idx < 512 ? 0.f : sigm(hg_lb[512 + k] - hg_lb[k]); }
        for (int m = gw; m < MP; m += NGW) xb_row(x + (size_t)m * DM, xb + (size_t)m * DM, ssq + (size_t)m * 16, lane);
    }
    grid.sync();
    const XcdBarrier xbar = xcd_barrier_post(barw, bst);

    for (int pass = 0; pass < NPASS; ++pass) {
        const size_t rb = (size_t)pass * MP;
        float* xres = a.out + rb * DM; const float* xin0 = x + rb * DM; float* ssqp = ssq + (size_t)pass * 5 * MP * 16;
        for (int l = 0; l < 2; ++l) {
            const bf16* wl = W + (size_t)l * L_ELEMS;
            const float* ssq_n1 = ssqp + (size_t)(l == 0 ? 0 : 2) * MP * 16; float* ssq_n2 = ssqp + (size_t)(l == 0 ? 1 : 3) * MP * 16; float* ssq_nx = ssqp + (size_t)(l == 0 ? 2 : 4) * MP * 16;
            for (int rep_ = 0; rep_ < REP_G1; ++rep_) {
            for (int call = 0; call < 3; ++call) {
                const int bld = 2 * call, Mv = call == 0 ? 1024 : 512, rowoff = call == 0 ? 0 : (call == 1 ? 1024 : 1536);
                const int cc = call == 2 ? (bx + G / 2) % G : bx;
                pg8::Gemm g{wl + W_V + (size_t)rowoff * 1024, xb, Mv, MP, 1024, bld}; pg8::StaticOrder S; S.init(Mv, MP, G, cc);
                EpiVT E{VT, ssq_n1, rowoff, bld};
                pg8::gemm_phase<EpiVT, pg8::StaticOrder, true, true>(lds, g, S, E);
            }
            {   pg8::Gemm g{xb, wl + W_MAIN, MP, NMAIN, 1024, 0}; pg8::StaticOrder S; S.init(MP, NMAIN, G, bx);
                EpiMain E{zbuf, gt, ssq_n1, lbv + l * 512, rc, rs};
                pg8::gemm_phase<EpiMain, pg8::StaticOrder, true, true>(lds, g, S, E); }
            }
            GSYNC();
            for (int rep_ = 0; rep_ < REP_HA; ++rep_) { unsigned lwA[8]; int t_ = threadIdx.x; asm volatile("" : "+v"(t_));
                if (bx < 1024) hgrn_a_loads(zbuf, bx, t_, lwA);
                for (int ch = bx; ch < 1024; ch += G) hgrn_passA(lds, zbuf, VT, KVT, dec, ch, ch + G, lwA); }
            for (int rep_ = 0; rep_ < REP_AU; ++rep_)
            for (int p_ = bx; p_ < 768; p_ += G) {
                const int bh_ = p_ / 48, q_ = p_ % 48, g_ = q_ >> 4, w_ = q_ & 15, ld_ = 2 * g_, r_ = w_ >> (4 - ld_), qt0_ = 2 * (w_ & ((16 >> ld_) - 1));
                bf16* ogp_ = g_ == 0 ? ohg : (g_ == 1 ? oatt : og2); float* lsep_ = lsev + (size_t)g_ * MP * 4;
                attn_unit(lds, zbuf, VT, ogp_, lsep_, bh_, g_, r_, qt0_, false);
                attn_unit(lds, zbuf, VT, ogp_, lsep_, bh_, g_, r_, qt0_ + 1, true); }
            GSYNC();
            int t2_ = threadIdx.x; asm volatile("" : "+v"(t2_));
            for (int rep_ = 0; rep_ < REP_ATT; ++rep_) attn_merge(ohg, oatt, og2, lsev, lsev + (size_t)MP * 4, lsev + (size_t)2 * MP * 4, oatt, bx * 512 + t2_, G * 512);
            for (int rep_ = 0; rep_ < REP_HS; ++rep_) hgrn_scan(KVT, dec, ST, bx * 512 + t2_, G * 512);
            GSYNC();
            for (int rep_ = 0; rep_ < REP_HC; ++rep_) { unsigned lwC[8], qwC[8]; int t_ = threadIdx.x; asm volatile("" : "+v"(t_));
                if (bx < 1024) hgrn_c_loads(zbuf, bx, t_, lwC, qwC);
                for (int ch = bx; ch < 1024; ch += G) hgrn_passC(lds, zbuf, VT, ST, hg_norm_g + l * 512, ohg, ch, ch + G, lwC, qwC); }
            GSYNC();
            for (int rep_ = 0; rep_ < REP_P3; ++rep_) {
                pg8::Gemm g{ohg, wl + W_A, MP, DM, 512, 0, oatt, wl + W_B}; pg8::ChainOrder S; S.init(MP, DM, G, bx); EpiGateChain E{gt, ybuf};
                pg8::gemm_phase<EpiGateChain, pg8::ChainOrder, true, true>(lds, g, S, E); }
            GSYNC();
            {   pg8::Gemm g{ybuf, wl + W_OUT, MP, DM, 1024, 0}; pg8::StaticOrder S; S.init(MP, DM, G, bx); EpiRes E{xb, ssq_n2};
                pg8::gemm_phase<EpiRes, pg8::StaticOrder, true, true>(lds, g, S, E); }
            GSYNC();
            for (int rep_ = 0; rep_ < REP_P5; ++rep_)
            {   pg8::Gemm g{xb, wl + W_UP, MP, FF, 1024, 0}; pg8::StaticOrder S; S.init(MP, FF, G, bx); EpiUp E{ubuf, ssq_n2};
                pg8::gemm_phase<EpiUp, pg8::StaticOrder, true, true>(lds, g, S, E); }
            GSYNC();
            {   pg8::Gemm g{ubuf, wl + W_DOWN, MP, DM, FF, 0}; pg8::StaticOrder S; S.init(MP, DM, G, bx); EpiRes E{xb, ssq_nx};
                pg8::gemm_phase<EpiRes, pg8::StaticOrder, true, true>(lds, g, S, E); }
            GSYNC();
        }
        int lane2 = lane; asm volatile("" : "+v"(lane2));
        for (int m = gw; m < MP; m += NGW) final_row(xb + (size_t)m * DM, xres + (size_t)m * DM, gfinal, lane2);
        if (pass + 1 < NPASS) {
            for (int m = gw; m < MP; m += NGW) xb_row(x + (rb + MP + m) * DM, xb + (size_t)m * DM, ssq + ((size_t)(pass + 1) * 5 * MP + m) * 16, lane2);
            GSYNC();
        }
    }
}

extern "C" void kernel_launch(void* const* d_in, const int* in_sizes, int n_in, void* d_out, int out_size, void* d_ws, size_t ws_size, hipStream_t stream) {
    static int grid = 0;
    if (grid == 0) {
        if (n_in != 12 || ws_size < WS_END) { fprintf(stderr, "kernel_launch: need 12 inputs and >= %zu bytes of workspace (got %d, %zu)\n", (size_t)WS_END, n_in, ws_size); grid = -1; return; }
        int dev = 0, cus = 0, per_cu = 0;
        hipGetDevice(&dev); hipDeviceGetAttribute(&cus, hipDeviceAttributeMultiprocessorCount, dev);
        hipFuncSetAttribute((const void*)hyb_fwd, hipFuncAttributeMaxDynamicSharedMemorySize, LDS_BYTES);
        hipOccupancyMaxActiveBlocksPerMultiprocessor(&per_cu, (const void*)hyb_fwd, 512, LDS_BYTES);
        if (per_cu < 1) per_cu = 1;
        grid = cus * per_cu;
        (void)hipGetLastError();
    }
    if (grid < 0) return;
    Args a{};
    for (int i = 0; i < 12; ++i) a.in[i] = (const float*)d_in[i];
    a.out = (float*)d_out; a.ws = (unsigned char*)d_ws;
    void* args[] = {&a};
    hipError_t e = hipLaunchCooperativeKernel((const void*)hyb_fwd, dim3(grid), dim3(512), args, LDS_BYTES, stream);
    if (e != hipSuccess) fprintf(stderr, "cooperative launch failed: %s (grid %d)\n", hipGetErrorString(e), grid);
}
```
